# Optimizing an MI355X kernel written in HIP

```python
import math
import jax, jax.numpy as jnp
from jax import lax
import numpy as np

D_MODEL = 2048
BATCH = 2
SEQ = 8192
DEPTH = 1

HEAD_DIM = 128
N_HEADS_TOTAL = D_MODEL // HEAD_DIM
N_HEADS_A = N_HEADS_TOTAL // 2
N_HEADS_B = N_HEADS_TOTAL - N_HEADS_A
DIFF_QK_DIM = HEAD_DIM // 2
WIDTH_A = N_HEADS_A * HEAD_DIM
WIDTH_B = N_HEADS_B * HEAD_DIM
MIX_WIDTH = WIDTH_A + WIDTH_B
IN_PROJ_WIDTH = 3 * WIDTH_A + 3 * WIDTH_B
DILATED_PATTERNS = ((128, 1), (512, 4), (2048, 16))
D_FF = -(-8 * D_MODEL // (3 * 256)) * 256
ROPE_THETA = 10000.0
RMS_EPS = 1e-6
Q_BLOCK = 128

kernel_name = "hymba_dilated_diffattn_swiglu_block"


def rmsnorm(x, g):
    xf = x.astype(jnp.float32)
    y = xf * lax.rsqrt(jnp.mean(xf * xf, axis=-1, keepdims=True) + RMS_EPS)
    return (y * g.astype(jnp.float32)).astype(x.dtype)


def rope(x, positions):
    e = x.shape[-1]
    half = e // 2
    inv = ROPE_THETA ** (-jnp.arange(half, dtype=jnp.float32) / half)
    ang = positions.astype(jnp.float32)[..., None] * inv
    ang = ang.reshape(ang.shape[:2] + (1,) * (x.ndim - 3) + (half,))
    cos, sin = jnp.cos(ang), jnp.sin(ang)
    xf = x.astype(jnp.float32)
    x1, x2 = xf[..., :half], xf[..., half:]
    return jnp.concatenate([x1 * cos - x2 * sin, x2 * cos + x1 * sin], axis=-1).astype(x.dtype)


def dilated_window_attention(q, k, v, window, dilation):
    B, S, H, E = q.shape
    n = window // dilation
    L = S // dilation
    nblk = -(-L // n)
    Lp = nblk * n

    def to_blocks(a):
        a = a.reshape(B, L, dilation, H, E)
        a = jnp.pad(a, ((0, 0), (0, Lp - L), (0, 0), (0, 0), (0, 0)))
        return a.reshape(B, nblk, n, dilation, H, E)

    def with_prev(a):
        prev = jnp.pad(a, ((0, 0), (1, 0), (0, 0), (0, 0), (0, 0), (0, 0)))[:, :-1]
        return jnp.concatenate([prev, a], axis=2)

    qb = to_blocks(q)
    kc = with_prev(to_blocks(k))
    vc = with_prev(to_blocks(v))

    s = jnp.einsum('bnqrhe,bnkrhe->bnrhqk', qb, kc).astype(jnp.float32)
    qi = jnp.arange(n)[:, None]
    kj = jnp.arange(2 * n)[None, :]
    dist = qi + n - kj
    band = (dist >= 0) & (dist <= n)
    blk = jnp.arange(nblk)[:, None, None]
    mask = band[None] & ((blk > 0) | (kj[None] >= n))
    s = jnp.where(mask[None, :, None, None], s, -jnp.inf)
    m = jnp.max(s, axis=-1, keepdims=True)
    p = jnp.exp(s - m)
    den = jnp.sum(p, axis=-1)
    o = jnp.einsum('bnrhqk,bnkrhe->bnqrhe', p, vc.astype(jnp.float32))
    o = o / den.transpose(0, 1, 4, 2, 3)[..., None]
    lse = (m[..., 0] + jnp.log(den)).transpose(0, 1, 4, 2, 3)
    o = o.reshape(B, Lp, dilation, H, E)[:, :L].reshape(B, S, H, E)
    lse = lse.reshape(B, Lp, dilation, H)[:, :L].reshape(B, S, H)
    return o, lse


def dilated_mixture_attention(q, k, v):
    outs, lses = [], []
    for window, dilation in DILATED_PATTERNS:
        o, lse = dilated_window_attention(q, k, v, window, dilation)
        outs.append(o)
        lses.append(lse)
    w = jax.nn.softmax(jnp.stack(lses, axis=0), axis=0)
    return jnp.sum(w[..., None] * jnp.stack(outs, axis=0), axis=0)


def differential_attention(q, k, v, lam):
    B, S, _, H, e = q.shape
    n_q = S // Q_BLOCK
    q_blocks = q.reshape(B, n_q, Q_BLOCK, 2, H, e).transpose(1, 0, 2, 3, 4, 5)
    kpos = jnp.arange(S)
    vf = v.astype(jnp.float32)

    def one_block(args):
        bi, qblk = args
        s = jnp.einsum('bqmhe,bkmhe->bmhqk', qblk, k).astype(jnp.float32)
        qpos = bi * Q_BLOCK + jnp.arange(Q_BLOCK)
        causal = kpos[None, :] <= qpos[:, None]
        s = jnp.where(causal, s, -jnp.inf)
        a = jax.nn.softmax(s, axis=-1)
        attn = a[:, 0] - lam * a[:, 1]
        return jnp.einsum('bhqk,bkhe->bqhe', attn, vf)

    out = lax.map(one_block, (jnp.arange(n_q), q_blocks))
    return out.transpose(1, 0, 2, 3, 4).reshape(B, S, H, v.shape[-1])


def setup_inputs(seed: int = 0) -> dict:
    key = jax.random.key(seed)
    ks = jax.random.split(key, 20)
    f32 = jnp.float32

    def nrm(k, shape, scale):
        return jax.random.normal(k, shape, f32) * scale

    def gain(k):
        return 1.0 + nrm(k, (DEPTH, D_MODEL), 0.05)

    x = jax.random.normal(ks[0], (BATCH, SEQ, D_MODEL), f32)
    c = jax.random.normal(ks[1], (BATCH, D_MODEL), f32)
    offset = jax.random.randint(ks[2], (BATCH, 1), 0, 4096, dtype=jnp.int32)
    positions = offset + jnp.arange(SEQ, dtype=jnp.int32)[None, :]
    return {
        "x": x,
        "c": c,
        "positions": positions,
        "w_ada": nrm(ks[3], (DEPTH, D_MODEL, 6 * D_MODEL), 0.5 * D_MODEL ** -0.5),
        "b_ada": nrm(ks[4], (DEPTH, 6 * D_MODEL), 0.02),
        "g_pre_attn": gain(ks[5]),
        "w_in": nrm(ks[6], (DEPTH, D_MODEL, IN_PROJ_WIDTH), D_MODEL ** -0.5),
        "g_out_a": 1.0 + nrm(ks[7], (DEPTH, HEAD_DIM), 0.05),
        "lambda_q1": nrm(ks[8], (DEPTH, DIFF_QK_DIM), 0.1),
        "lambda_k1": nrm(ks[9], (DEPTH, DIFF_QK_DIM), 0.1),
        "lambda_q2": nrm(ks[10], (DEPTH, DIFF_QK_DIM), 0.1),
        "lambda_k2": nrm(ks[11], (DEPTH, DIFF_QK_DIM), 0.1),
        "g_subln_b": 1.0 + nrm(ks[12], (DEPTH, HEAD_DIM), 0.05),
        "w_out": nrm(ks[13], (DEPTH, MIX_WIDTH, D_MODEL), MIX_WIDTH ** -0.5),
        "g_post_attn": gain(ks[14]),
        "g_pre_ffn": gain(ks[15]),
        "w_gate": nrm(ks[16], (DEPTH, D_MODEL, D_FF), D_MODEL ** -0.5),
        "w_up": nrm(ks[17], (DEPTH, D_MODEL, D_FF), D_MODEL ** -0.5),
        "w_down": nrm(ks[18], (DEPTH, D_FF, D_MODEL), D_FF ** -0.5),
        "g_post_ffn": gain(ks[19]),
    }


def reference(x, c, positions, w_ada, b_ada, g_pre_attn, w_in, g_out_a,
              lambda_q1, lambda_k1, lambda_q2, lambda_k2, g_subln_b, w_out,
              g_post_attn, g_pre_ffn, w_gate, w_up, w_down, g_post_ffn):
    B, S, _ = x.shape
    scale_a = HEAD_DIM ** -0.5
    scale_b = DIFF_QK_DIM ** -0.5
    for l in range(DEPTH):
        lambda_init = 0.8 - 0.6 * math.exp(-0.3 * l)
        mod = jax.nn.silu(c) @ w_ada[l] + b_ada[l]
        sh_a, sc_a, gt_a, sh_f, sc_f, gt_f = [m[:, None, :] for m in jnp.split(mod, 6, axis=-1)]

        h = rmsnorm(x, g_pre_attn[l]) * (1.0 + sc_a) + sh_a
        proj = h @ w_in[l]
        qa, ka, va, qb, kb, vb = jnp.split(proj, 6, axis=-1)

        qa = rope(qa.reshape(B, S, N_HEADS_A, HEAD_DIM), positions) * scale_a
        ka = rope(ka.reshape(B, S, N_HEADS_A, HEAD_DIM), positions)
        va = va.reshape(B, S, N_HEADS_A, HEAD_DIM)
        oa = dilated_mixture_attention(qa, ka, va).astype(x.dtype)
        oa = rmsnorm(oa, g_out_a[l])

        qb = rope(qb.reshape(B, S, 2, N_HEADS_B, DIFF_QK_DIM), positions) * scale_b
        kb = rope(kb.reshape(B, S, 2, N_HEADS_B, DIFF_QK_DIM), positions)
        vb = vb.reshape(B, S, N_HEADS_B, HEAD_DIM)
        lam = (jnp.exp(jnp.sum(lambda_q1[l].astype(jnp.float32) * lambda_k1[l].astype(jnp.float32)))
               - jnp.exp(jnp.sum(lambda_q2[l].astype(jnp.float32) * lambda_k2[l].astype(jnp.float32)))
               + lambda_init)
        ob = differential_attention(qb, kb, vb, lam).astype(x.dtype)
        ob = rmsnorm(ob, g_subln_b[l]) * (1.0 - lambda_init)

        mix = jnp.concatenate([oa.reshape(B, S, WIDTH_A), ob.reshape(B, S, WIDTH_B)], axis=-1)
        x = x + gt_a * rmsnorm(mix @ w_out[l], g_post_attn[l])

        h = rmsnorm(x, g_pre_ffn[l]) * (1.0 + sc_f) + sh_f
        f = (jax.nn.silu(h @ w_gate[l]) * (h @ w_up[l])) @ w_down[l]
        x = x + gt_f * rmsnorm(f, g_post_ffn[l])
    return x
```

```cpp
#include <hip/hip_runtime.h>
#include <hip/hip_bf16.h>
#include <hip/hip_cooperative_groups.h>
#include <cstdio>
#include <cstdint>
#include <cmath>
namespace pg8 {
#define PG8_LAS __attribute__((address_space(3)))
typedef unsigned short bf16_t;
typedef short bf16x8 __attribute__((ext_vector_type(8)));
typedef float f32x4 __attribute__((ext_vector_type(4)));
typedef unsigned u32x4 __attribute__((ext_vector_type(4)));
constexpr int BM = 256, BK = 64, HALF = 128, HTB = HALF * BK * 2  , STAGE_BYTES = 8 * HTB, NXCD = 8, WGM = 8;

__host__ __device__ __forceinline__ int lds_byte(int r, int c) { const int st = (r >> 4) * 2 + (c >> 5), rr = r & 15, cc = c & 31, ob = rr * 64 + cc * 2; return st * 1024 + (ob ^ (((ob >> 9) & 1) << 5)); }
__host__ __device__ __forceinline__ void stage_rc(int b, int& R, int& C) { const int st = b / 1024, sb = b % 1024, swz = sb ^ (((sb >> 9) & 1) << 5); R = (st >> 1) * 16 + swz / 64; C = (st & 1) * 32 + (swz % 64) / 2; }
__host__ __device__ __forceinline__ int perm32(int rho) { const int n = rho >> 4, i = rho & 15; return 8 * (i >> 2) + 4 * n + (i & 3); }

struct Unit { int pm, pn; };
struct Gemm { const bf16_t* A; const bf16_t* Bt; int M, N, K; };

struct StaticOrder {
    int nM, nN, nwg, G, c;
    __host__ __device__ void init(int M, int N, int G_, int c_) { nM = M / BM; nN = N / BM; nwg = nM * nN; G = G_; c = c_; }
    __host__ __device__ bool next(int i, Unit& u) const {
        const long L = (long)i * G + c; if (L >= nwg) return false;
        int wgid = (int)L; { const int q = nwg / NXCD, r = nwg % NXCD, xcd = wgid % NXCD, off = wgid / NXCD; wgid = (xcd < r ? xcd * (q + 1) : r * (q + 1) + (xcd - r) * q) + off; }
        const int nig = WGM * nN, gid = wgid / nig, fm = gid * WGM, gsz = (nM - fm) < WGM ? (nM - fm) : WGM;
        u.pm = fm + ((wgid % nig) % gsz); u.pn = (wgid % nig) / gsz; return true;
    }
    __device__ __forceinline__ void a_ready(const Unit&) const {}
    __device__ __forceinline__ void done(const Unit&) const {}
};

__device__ __forceinline__ unsigned cvt_pk_bf16(float lo, float hi) { unsigned r; asm volatile("v_cvt_pk_bf16_f32 %0, %1, %2" : "=v"(r) : "v"(lo), "v"(hi)); return r; }
typedef float f32x2 __attribute__((ext_vector_type(2)));
__device__ __forceinline__ f32x2 gelu_pk(f32x2 v) {
    const f32x2 av = __builtin_elementwise_abs(v), d = av * 0.2316418882f + 1.0f;
    f32x2 t; t.x = __builtin_amdgcn_rcpf(d.x); t.y = __builtin_amdgcn_rcpf(d.y);
    f32x2 q = t * 0.5307027145f + (-0.7265760135f); q = q * t + 0.7107068705f; q = q * t + (-0.142248368f); q = q * t + 0.127414796f; q = q * t;
    const f32x2 s = (v * v) * (-0.72134752044f);
    f32x2 e; e.x = __builtin_amdgcn_exp2f(s.x); e.y = __builtin_amdgcn_exp2f(s.y);
    const f32x2 m = v * (q * e), r = v - m;
    f32x2 o; o.x = v.x < 0.f ? m.x : r.x; o.y = v.y < 0.f ? m.y : r.y; return o;
}

template <int ACT  > struct EpiBf16 {
    static constexpr bool PERM = true, AFTER_DRAIN = false; static_assert(ACT == 0 || ACT == 1, "EpiBf16: ACT is 0 (none) or 1 (gelu_pk)");
    bf16_t* O; int ldc; const float* bias; int split_cols; size_t split_stride; float scale0;
    __device__ __forceinline__ void operator()(const f32x4 (&acc)[2][2][4][2], const Unit& u, int wr, int wc, int fr, int fq) const {
        const int row0 = u.pm * BM + wr * 64 + fr; int colt = u.pn * BM; bf16_t* base = O;
        float sc = 1.f; if (split_cols) { const int t = colt / split_cols; base += (size_t)t * split_stride; colt -= t * split_cols; if (t == 0) sc = scale0; }
        const int col0 = colt + wc * 32 + 8 * fq, bcol0 = u.pn * BM + wc * 32 + 8 * fq;
        f32x4 bv[2][2];
#pragma unroll
        for (int bj = 0; bj < 2; ++bj)
#pragma unroll
            for (int n = 0; n < 2; ++n) bv[bj][n] = bias ? *(const f32x4*)(bias + bcol0 + bj * HALF + 4 * n) : (f32x4){0.f, 0.f, 0.f, 0.f};
#pragma unroll
        for (int ai = 0; ai < 2; ++ai)
#pragma unroll
            for (int m = 0; m < 4; ++m) { bf16_t* rowp = base + (size_t)(row0 + ai * HALF + m * 16) * ldc + col0;
#pragma unroll
                for (int bj = 0; bj < 2; ++bj) { f32x4 v0 = acc[ai][bj][m][0] + bv[bj][0], v1 = acc[ai][bj][m][1] + bv[bj][1];
                    if (ACT == 1) { f32x2 a = gelu_pk((f32x2){v0[0], v0[1]}), b = gelu_pk((f32x2){v0[2], v0[3]}), c = gelu_pk((f32x2){v1[0], v1[1]}), d = gelu_pk((f32x2){v1[2], v1[3]});
                        v0 = (f32x4){a.x, a.y, b.x, b.y}; v1 = (f32x4){c.x, c.y, d.x, d.y}; }
                    v0 = v0 * sc; v1 = v1 * sc; u32x4 w; w.x = cvt_pk_bf16(v0[0], v0[1]); w.y = cvt_pk_bf16(v0[2], v0[3]); w.z = cvt_pk_bf16(v1[0], v1[1]); w.w = cvt_pk_bf16(v1[2], v1[3]);
                    *(u32x4*)(rowp + bj * HALF) = w; } }
    }
};
__device__ __forceinline__ u32x4 pack8bf(const f32x4 a, const f32x4 b) { u32x4 w; w.x = cvt_pk_bf16(a[0], a[1]); w.y = cvt_pk_bf16(a[2], a[3]); w.z = cvt_pk_bf16(b[0], b[1]); w.w = cvt_pk_bf16(b[2], b[3]); return w; }
struct EpiInProj {
    static constexpr bool PERM = true, AFTER_DRAIN = false;
    unsigned char* ws; float qscale;
    static constexpr size_t M_ = 1u << 20, O_CSA = 6 * M_, O_CSB = 14 * M_, O_QA = 180 * M_, O_KA = 212 * M_, O_VA = 244 * M_, O_QB = 276 * M_, O_KB = 308 * M_, O_VB = 340 * M_;
    __device__ __forceinline__ void operator()(const f32x4 (&acc)[2][2][4][2], const Unit& u, int wr, int wc, int fr, int fq) const {
        const int kind = u.pn >> 2, tq = u.pn & 3, j0 = wc * 32 + 8 * fq, row0 = u.pm * BM + wr * 64 + fr;
        if (kind == 0 || kind == 1) {
            bf16_t* base = (bf16_t*)(ws + (kind == 0 ? O_QA : O_KA)); const float* csA = (const float*)(ws + O_CSA); const int hl = j0 >> 6, e0 = j0 & 63, head = 2 * tq + hl;
#pragma unroll
            for (int ai = 0; ai < 2; ++ai)
#pragma unroll
                for (int m = 0; m < 4; ++m) { const int t = row0 + ai * HALF + m * 16, b = t >> 13, s = t & 8191;
                    const f32x4* cs = (const f32x4*)(csA + ((size_t)t * 64 + e0) * 2); const f32x4 c0 = cs[0], c1 = cs[1], c2 = cs[2], c3 = cs[3];
                    const f32x4 coa = {c0[0], c0[2], c1[0], c1[2]}, sia = {c0[1], c0[3], c1[1], c1[3]}, cob = {c2[0], c2[2], c3[0], c3[2]}, sib = {c2[1], c2[3], c3[1], c3[3]};
                    const f32x4 x1a = acc[ai][0][m][0], x1b = acc[ai][0][m][1], x2a = acc[ai][1][m][0], x2b = acc[ai][1][m][1];
                    const f32x4 y1a = x1a * coa - x2a * sia, y1b = x1b * cob - x2b * sib, y2a = x2a * coa + x1a * sia, y2b = x2b * cob + x1b * sib;
                    bf16_t* dst = base + ((size_t)(b * 8 + head) * 8192 + s) * 128 + e0;
                    *(u32x4*)dst = pack8bf(y1a, y1b); *(u32x4*)(dst + 64) = pack8bf(y2a, y2b); }
        } else if (kind == 2) {
#pragma unroll
            for (int ai = 0; ai < 2; ++ai)
#pragma unroll
                for (int m = 0; m < 4; ++m) { const int t = row0 + ai * HALF + m * 16, b = t >> 13, s = t & 8191;
#pragma unroll
                    for (int bj = 0; bj < 2; ++bj) { bf16_t* dst = (bf16_t*)(ws + O_VA) + ((size_t)(b * 8 + 2 * tq + bj) * 8192 + s) * 128 + j0; *(u32x4*)dst = pack8bf(acc[ai][bj][m][0], acc[ai][bj][m][1]); } }
        } else if (kind == 3 || kind == 4) {
            bf16_t* base = (bf16_t*)(ws + (kind == 3 ? O_QB : O_KB)); const float* csB = (const float*)(ws + O_CSB); const float sc = kind == 3 ? qscale : 1.0f; const int hl = j0 >> 5, e0 = j0 & 31, col = 256 * tq + hl * 64 + e0;
#pragma unroll
            for (int ai = 0; ai < 2; ++ai)
#pragma unroll
                for (int m = 0; m < 4; ++m) { const int t = row0 + ai * HALF + m * 16;
                    const f32x4* cs = (const f32x4*)(csB + ((size_t)t * 32 + e0) * 2); const f32x4 c0 = cs[0], c1 = cs[1], c2 = cs[2], c3 = cs[3];
                    const f32x4 coa = {c0[0], c0[2], c1[0], c1[2]}, sia = {c0[1], c0[3], c1[1], c1[3]}, cob = {c2[0], c2[2], c3[0], c3[2]}, sib = {c2[1], c2[3], c3[1], c3[3]};
                    const f32x4 x1a = acc[ai][0][m][0], x1b = acc[ai][0][m][1], x2a = acc[ai][1][m][0], x2b = acc[ai][1][m][1];
                    const f32x4 y1a = (x1a * coa - x2a * sia) * sc, y1b = (x1b * cob - x2b * sib) * sc, y2a = (x2a * coa + x1a * sia) * sc, y2b = (x2b * cob + x1b * sib) * sc;
                    bf16_t* dst = base + (size_t)t * 1024 + col;
                    *(u32x4*)dst = pack8bf(y1a, y1b); *(u32x4*)(dst + 32) = pack8bf(y2a, y2b); }
        } else {
#pragma unroll
            for (int ai = 0; ai < 2; ++ai)
#pragma unroll
                for (int m = 0; m < 4; ++m) { const int t = row0 + ai * HALF + m * 16;
#pragma unroll
                    for (int bj = 0; bj < 2; ++bj) { bf16_t* dst = (bf16_t*)(ws + O_VB) + (size_t)t * 1024 + 256 * tq + 128 * bj + j0; *(u32x4*)dst = pack8bf(acc[ai][bj][m][0], acc[ai][bj][m][1]); } }
        }
    }
};
struct EpiF32Ssq {
    static constexpr bool PERM = false, AFTER_DRAIN = false;
    float* Y; int ldc; float* ssq;
    __device__ __forceinline__ void operator()(const f32x4 (&acc)[2][2][4][2], const Unit& u, int wr, int wc, int fr, int fq) const {
        const int col0 = u.pn * BM + wc * 32 + 4 * fq;
#pragma unroll
        for (int ai = 0; ai < 2; ++ai)
#pragma unroll
            for (int m = 0; m < 4; ++m) { const int row = u.pm * BM + ai * HALF + wr * 64 + m * 16 + fr; float s = 0.f; float* yr = Y + (size_t)row * ldc + col0;
#pragma unroll
                for (int bj = 0; bj < 2; ++bj)
#pragma unroll
                    for (int n = 0; n < 2; ++n) { const f32x4 v = acc[ai][bj][m][n]; *(f32x4*)(yr + bj * HALF + n * 16) = v; s += (v[0] * v[0] + v[1] * v[1]) + (v[2] * v[2] + v[3] * v[3]); }
                s += __shfl_xor(s, 16); s += __shfl_xor(s, 32);
                if (fq == 0) ssq[(size_t)row * 32 + u.pn * 4 + wc] = s; }
    }
};
struct EpiSwiGLU {
    static constexpr bool PERM = true, AFTER_DRAIN = false;
    bf16_t* O; int ldc;
    __device__ __forceinline__ void operator()(const f32x4 (&acc)[2][2][4][2], const Unit& u, int wr, int wc, int fr, int fq) const {
        const int col0 = u.pn * HALF + wc * 32 + 8 * fq, row0 = u.pm * BM + wr * 64 + fr;
#pragma unroll
        for (int ai = 0; ai < 2; ++ai)
#pragma unroll
            for (int m = 0; m < 4; ++m) { f32x4 r[2];
#pragma unroll
                for (int n = 0; n < 2; ++n) { const f32x4 g = acc[ai][0][m][n], up = acc[ai][1][m][n];
#pragma unroll
                    for (int i = 0; i < 4; ++i) { const float e = __builtin_amdgcn_exp2f(-1.4426950408889634f * g[i]); r[n][i] = g[i] * __builtin_amdgcn_rcpf(1.0f + e) * up[i]; } }
                *(u32x4*)(O + (size_t)(row0 + ai * HALF + m * 16) * ldc + col0) = pack8bf(r[0], r[1]); }
    }
};
template <class Epi, class Sched, bool ALIGN_EPI = false, bool SP2 = false>
__device__ __forceinline__ void gemm_phase(PG8_LAS unsigned char* lds, const Gemm g, const Sched& S, const Epi& E) {
    const int tid = threadIdx.x, wid = __builtin_amdgcn_readfirstlane(tid >> 6), lane = tid & 63, wr = wid >> 2, wc = wid & 3, fr = lane & 15, fq = lane >> 4;
    const int K = g.K, nt = K / BK;
    unsigned voffA[2], voffB[2];
#pragma unroll
    for (int i = 0; i < 2; ++i) { int R, C; stage_rc(tid * 16 + i * 8192, R, C); const int Rb = Epi::PERM ? ((R & ~31) + perm32(R & 31)) : R;
        voffA[i] = (unsigned)(R * K + C) * 2u; voffB[i] = (unsigned)(Rb * K + C) * 2u; }
    const size_t kstep = (size_t)(BK * 2);
    const size_t hstep = (size_t)HALF * K * 2;
    const size_t tstep = 2 * hstep;
    const unsigned ldsw = (unsigned)wid * 1024u;
    const int aoff = lds_byte(wr * 64 + fr, fq * 8), boff = lds_byte(wc * 32 + fr, fq * 8);
#define PG8_SA(b, h) (((b) * 2 + (h)) * HTB)
#define PG8_SB(b, h) ((4 + (b) * 2 + (h)) * HTB)
#define PG8_STAGE(bufoff, gbase, voff) do { _Pragma("unroll") for (int _i = 0; _i < 2; ++_i) \
        __builtin_amdgcn_global_load_lds((const unsigned*)((const char*)(gbase) + (voff)[_i]), (PG8_LAS unsigned*)(lds + (bufoff) + ldsw + _i * 8192), 16, 0, 0); } while (0)
#define PG8_LDA(dst, b, h) do { _Pragma("unroll") for (int m = 0; m < 4; ++m) _Pragma("unroll") for (int k = 0; k < 2; ++k) dst[m][k] = *(const PG8_LAS bf16x8*)(lds + PG8_SA(b, h) + aoff + m * 2048 + k * 1024); } while (0)
#define PG8_LDB(dst, b, h) do { _Pragma("unroll") for (int n = 0; n < 2; ++n) _Pragma("unroll") for (int k = 0; k < 2; ++k) dst[n][k] = *(const PG8_LAS bf16x8*)(lds + PG8_SB(b, h) + boff + n * 2048 + k * 1024); } while (0)
#define PG8_MMA(ai, bj, At, Bt) do { __builtin_amdgcn_s_setprio(1); _Pragma("unroll") for (int m = 0; m < 4; ++m) _Pragma("unroll") for (int n = 0; n < 2; ++n) _Pragma("unroll") for (int k = 0; k < 2; ++k) \
        acc[ai][bj][m][n] = __builtin_amdgcn_mfma_f32_16x16x32_bf16(Bt[n][k], At[m][k], acc[ai][bj][m][n], 0, 0, 0); __builtin_amdgcn_s_setprio(0); } while (0)
#define PG8_WAIT_V(n) asm volatile("s_waitcnt vmcnt(" #n ")" ::: "memory")
#define PG8_WAIT_L(n) asm volatile("s_waitcnt lgkmcnt(" #n ")" ::: "memory")
#define PG8_BAR __builtin_amdgcn_s_barrier()
#define PG8_SCHED __builtin_amdgcn_sched_barrier(0)
    Unit cur, nxt; int ui = 0;
    if (!S.next(0, cur)) return;
    f32x4 acc[2][2][4][2];
#pragma unroll
    for (int a = 0; a < 2; ++a)
#pragma unroll
        for (int b = 0; b < 2; ++b)
#pragma unroll
            for (int m = 0; m < 4; ++m)
#pragma unroll
                for (int n = 0; n < 2; ++n) acc[a][b][m][n] = (f32x4){0.f, 0.f, 0.f, 0.f};
    bf16x8 At[4][2], B0[2][2], B1[2][2];
    const char* cA = (const char*)g.A + (size_t)cur.pm * tstep; const char* cB = (const char*)g.Bt + (size_t)cur.pn * tstep;
    S.a_ready(cur);
    if constexpr (SP2) {
        PG8_STAGE(PG8_SB(0, 0), cB, voffB); PG8_STAGE(PG8_SB(0, 1), cB + hstep, voffB); PG8_STAGE(PG8_SA(0, 0), cA, voffA); PG8_STAGE(PG8_SA(0, 1), cA + hstep, voffA);
        if (wr == 1) PG8_BAR;
        PG8_WAIT_V(2); PG8_BAR;
        PG8_STAGE(PG8_SB(1, 0), cB + kstep, voffB); PG8_STAGE(PG8_SA(1, 0), cA + kstep, voffA); PG8_STAGE(PG8_SB(1, 1), cB + hstep + kstep, voffB);
        PG8_WAIT_V(6); PG8_BAR;
    } else {
        PG8_STAGE(PG8_SB(0, 0), cB, voffB); PG8_STAGE(PG8_SA(0, 0), cA, voffA); PG8_STAGE(PG8_SB(0, 1), cB + hstep, voffB); PG8_STAGE(PG8_SA(0, 1), cA + hstep, voffA);
        if (wr == 1) PG8_BAR;
        PG8_WAIT_V(4); PG8_BAR;
        PG8_STAGE(PG8_SB(1, 0), cB + kstep, voffB); PG8_STAGE(PG8_SA(1, 0), cA + kstep, voffA); PG8_STAGE(PG8_SB(1, 1), cB + hstep + kstep, voffB);
        PG8_WAIT_V(6); PG8_BAR;
    }
    for (;;) {
        const bool has_next = S.next(ui + 1, nxt);
        const char* nA = has_next ? (const char*)g.A + (size_t)nxt.pm * tstep : cA; const char* nB = has_next ? (const char*)g.Bt + (size_t)nxt.pn * tstep : cB;
        for (int t = 0; t < nt; t += 2) {
            const bool last = (t == nt - 2);
            const char* a1 = cA + (size_t)(t + 1) * kstep;
            const char* a2 = last ? nA : cA + (size_t)(t + 2) * kstep; const char* b2 = last ? nB : cB + (size_t)(t + 2) * kstep;
            const char* a3 = a2 + kstep; const char* b3 = b2 + kstep;
            if (last && has_next) S.a_ready(nxt);
            if constexpr (SP2) {
            PG8_LDB(B0, 0, 0); PG8_LDB(B1, 0, 1); PG8_SCHED; PG8_LDA(At, 0, 0); PG8_STAGE(PG8_SA(1, 1), a1 + hstep, voffA);
            PG8_WAIT_V(8); PG8_WAIT_L(0); PG8_BAR; PG8_MMA(0, 0, At, B0); PG8_MMA(0, 1, At, B1); PG8_BAR; PG8_SCHED;
            PG8_LDA(At, 0, 1); PG8_STAGE(PG8_SB(0, 0), b2, voffB); PG8_STAGE(PG8_SB(0, 1), b2 + hstep, voffB); PG8_STAGE(PG8_SA(0, 0), a2, voffA);
            PG8_WAIT_V(8); PG8_WAIT_L(0); PG8_BAR; PG8_MMA(1, 0, At, B0); PG8_MMA(1, 1, At, B1); PG8_BAR; PG8_SCHED;
            PG8_LDB(B0, 1, 0); PG8_LDB(B1, 1, 1); PG8_SCHED; PG8_LDA(At, 1, 0); PG8_STAGE(PG8_SA(0, 1), a2 + hstep, voffA);
            PG8_WAIT_V(8); PG8_WAIT_L(0); PG8_BAR; PG8_MMA(0, 0, At, B0); PG8_MMA(0, 1, At, B1); PG8_BAR; PG8_SCHED;
            PG8_LDA(At, 1, 1); PG8_STAGE(PG8_SB(1, 0), b3, voffB); PG8_STAGE(PG8_SB(1, 1), b3 + hstep, voffB); PG8_STAGE(PG8_SA(1, 0), a3, voffA);
            PG8_WAIT_V(8); PG8_WAIT_L(0); PG8_BAR; PG8_MMA(1, 0, At, B0); PG8_MMA(1, 1, At, B1); PG8_BAR; PG8_SCHED;
            } else {
            PG8_LDB(B0, 0, 0); PG8_SCHED; PG8_LDA(At, 0, 0); PG8_STAGE(PG8_SA(1, 1), a1 + hstep, voffA);
            PG8_WAIT_L(8); PG8_BAR; PG8_WAIT_L(0); PG8_MMA(0, 0, At, B0); PG8_BAR; PG8_SCHED;
            PG8_LDB(B1, 0, 1); PG8_STAGE(PG8_SB(0, 0), b2, voffB);
            PG8_BAR; PG8_WAIT_L(0); PG8_MMA(0, 1, At, B1); PG8_BAR;
            PG8_LDA(At, 0, 1); PG8_STAGE(PG8_SA(0, 0), a2, voffA);
            PG8_BAR; PG8_WAIT_L(0); PG8_MMA(1, 0, At, B0); PG8_BAR; PG8_SCHED;
            PG8_STAGE(PG8_SB(0, 1), b2 + hstep, voffB);
            PG8_WAIT_V(6); PG8_BAR; PG8_MMA(1, 1, At, B1); PG8_BAR;
            PG8_LDB(B0, 1, 0); PG8_SCHED; PG8_LDA(At, 1, 0); PG8_STAGE(PG8_SA(0, 1), a2 + hstep, voffA);
            PG8_WAIT_L(8); PG8_BAR; PG8_WAIT_L(0); PG8_MMA(0, 0, At, B0); PG8_BAR; PG8_SCHED;
            PG8_LDB(B1, 1, 1); PG8_STAGE(PG8_SB(1, 0), b3, voffB);
            PG8_BAR; PG8_WAIT_L(0); PG8_MMA(0, 1, At, B1); PG8_BAR;
            PG8_LDA(At, 1, 1); PG8_STAGE(PG8_SA(1, 0), a3, voffA);
            PG8_BAR; PG8_WAIT_L(0); PG8_MMA(1, 0, At, B0); PG8_BAR; PG8_SCHED;
            PG8_STAGE(PG8_SB(1, 1), b3 + hstep, voffB);
            PG8_WAIT_V(6); PG8_BAR; PG8_MMA(1, 1, At, B1); PG8_BAR;
            }
        }
        if constexpr (ALIGN_EPI) { if (wr == 0) PG8_BAR; }
        if constexpr (!Epi::AFTER_DRAIN) { E(acc, cur, wr, wc, fr, fq); S.done(cur); }
        if (!has_next) break;
#pragma unroll
        for (int a = 0; a < 2; ++a)
#pragma unroll
            for (int b = 0; b < 2; ++b)
#pragma unroll
                for (int m = 0; m < 4; ++m)
#pragma unroll
                    for (int n = 0; n < 2; ++n) acc[a][b][m][n] = (f32x4){0.f, 0.f, 0.f, 0.f};
        cur = nxt; cA = nA; cB = nB; ++ui;
        if constexpr (ALIGN_EPI) { if (wr == 1) PG8_BAR; }
    }
    PG8_WAIT_V(0);
    if constexpr (!ALIGN_EPI) { if (wr == 0) PG8_BAR; }
    PG8_BAR;
    if constexpr (Epi::AFTER_DRAIN) { E.fused(acc, cur, wr, wc, fr, fq, lds, wid, lane); S.done(cur); }
#undef PG8_SA
#undef PG8_SB
#undef PG8_STAGE
#undef PG8_LDA
#undef PG8_LDB
#undef PG8_MMA
#undef PG8_WAIT_V
#undef PG8_WAIT_L
#undef PG8_BAR
#undef PG8_SCHED
}
}
namespace attn_body {
using bf16=__hip_bfloat16;
using bf16x8=__attribute__((ext_vector_type(8)))short;
using s16x4=__attribute__((ext_vector_type(4)))short;
using f32x16=__attribute__((ext_vector_type(16)))float;
using u32x4=__attribute__((ext_vector_type(4)))unsigned;
constexpr int BATCH=2,NHEAD=16,SEQ=8192,D=64,DM=NHEAD*D;
constexpr int NW=8,QBLK=32,QB=QBLK*NW,KVBLK=64,NQB=SEQ/QB;
constexpr int ATTN_PITCH=DM, ATTN_UNIT_ROWS=QB;
__device__ __forceinline__ int crow(int r,int hi){return (r&3)+8*(r>>2)+4*hi;}
#define SBAR() __builtin_amdgcn_sched_barrier(0)
__device__ __forceinline__ void cmask(f32x16&p0,f32x16&p1,int jb,int qrel,int hi){
  const float NEG=-INFINITY; int kb=64*jb+4*hi;
  #pragma unroll
  for(int r=0;r<16;++r){int kv=kb+(r&3)+8*(r>>2); if(kv>qrel)p0[r]=NEG; if(kv+32>qrel)p1[r]=NEG;}
}

constexpr int NSLOT=3, SLOTB=8192;
constexpr int LDS_K=0, LDS_V=NSLOT*SLOTB, LDS_WS=2*NSLOT*SLOTB, LDS_OST=LDS_WS+NW*64*4, LDS_BYTES=LDS_OST+NW*4096;
constexpr float C2=0.125f*1.4426950408889634f;
__device__ __forceinline__ void glds16(const void*gsrc,unsigned lds_dst){unsigned keep;
  asm volatile("s_mov_b32 %0, m0\n\ts_mov_b32 m0, %2\n\ts_nop 0\n\tglobal_load_lds_dwordx4 %1, off\n\ts_mov_b32 m0, %0":"=&s"(keep):"v"(gsrc),"s"(lds_dst):"memory");}
__device__ __forceinline__ float max3f(float a,float b,float c){float r;asm("v_max3_f32 %0, %1, %2, %3":"=v"(r):"v"(a),"v"(b),"v"(c));return r;}
__device__ __forceinline__ float max2f(float a,float b){float r;asm("v_max_f32_e32 %0, %1, %2":"=v"(r):"v"(a),"v"(b));return r;}
__device__ __forceinline__ float fadd_s(float a,float b){float r;asm("v_add_f32_e32 %0, %1, %2":"=v"(r):"v"(a),"v"(b));return r;}
__device__ __forceinline__ float fsub_s(float a,float b){float r;asm("v_sub_f32_e32 %0, %1, %2":"=v"(r):"v"(a),"v"(b));return r;}
typedef float f32x2_t __attribute__((ext_vector_type(2))); typedef __bf16 bf16x2_t __attribute__((ext_vector_type(2)));
__device__ __forceinline__ unsigned cvtpk_s(float lo,float hi){f32x2_t v={lo,hi};bf16x2_t b=__builtin_convertvector(v,bf16x2_t);return __builtin_bit_cast(unsigned,b);}
#define WAIT_BAR(N) asm volatile("s_waitcnt vmcnt(" #N ") lgkmcnt(0)\n\ts_barrier":::"memory")

__device__ __forceinline__ void qkt(f32x16&p0,f32x16&p1,const char*Kslot,const bf16x8*qr,const f32x16&negm,int r32,int hi){
  const char*kb=Kslot+hi*1024+r32*16;
  #pragma unroll
  for(int d0=0;d0<4;++d0){
    const bf16x8 b0=*reinterpret_cast<const bf16x8*>(kb+d0*2048);
    const bf16x8 b1=*reinterpret_cast<const bf16x8*>(kb+d0*2048+512);
    if(d0==0){p0=__builtin_amdgcn_mfma_f32_32x32x16_bf16(b0,qr[0],negm,0,0,0);p1=__builtin_amdgcn_mfma_f32_32x32x16_bf16(b1,qr[0],negm,0,0,0);}
    else{p0=__builtin_amdgcn_mfma_f32_32x32x16_bf16(b0,qr[d0],p0,0,0,0);p1=__builtin_amdgcn_mfma_f32_32x32x16_bf16(b1,qr[d0],p1,0,0,0);}}
}
typedef __attribute__((address_space(3))) const char* lds_cptr;
typedef short v4i16_t __attribute__((ext_vector_type(4)));
__device__ __forceinline__ void kload8(bf16x8*kf,lds_cptr kp){
  kf[0]=*(const __attribute__((address_space(3))) bf16x8*)(kp);      kf[1]=*(const __attribute__((address_space(3))) bf16x8*)(kp+512);
  kf[2]=*(const __attribute__((address_space(3))) bf16x8*)(kp+2048); kf[3]=*(const __attribute__((address_space(3))) bf16x8*)(kp+2560);
  kf[4]=*(const __attribute__((address_space(3))) bf16x8*)(kp+4096); kf[5]=*(const __attribute__((address_space(3))) bf16x8*)(kp+4608);
  kf[6]=*(const __attribute__((address_space(3))) bf16x8*)(kp+6144); kf[7]=*(const __attribute__((address_space(3))) bf16x8*)(kp+6656);
}
__device__ __forceinline__ void kload2(bf16x8*kf,lds_cptr kp,int j){ kf[2*j]=*(const __attribute__((address_space(3))) bf16x8*)(kp+j*2048); kf[2*j+1]=*(const __attribute__((address_space(3))) bf16x8*)(kp+j*2048+512); }
__device__ __forceinline__ s16x4 vtr(lds_cptr p){ return __builtin_bit_cast(s16x4,__builtin_amdgcn_ds_read_tr16_b64_v4i16((__attribute__((address_space(3))) v4i16_t*)p)); }
__device__ __forceinline__ float rowmax(const f32x16&p0,const f32x16&p1){
  float a=max3f(p0[0],p0[1],p1[0]),b=max3f(p0[2],p0[3],p1[1]);a=max3f(a,p1[2],p1[3]);
  #pragma unroll
  for(int r=4;r<16;r+=4){a=max3f(a,p0[r],p0[r+1]);b=max3f(b,p0[r+2],p0[r+3]);a=max3f(a,p1[r],p1[r+1]);b=max3f(b,p1[r+2],p1[r+3]);}
  const float m=max2f(a,b);
  auto rr=__builtin_amdgcn_permlane32_swap(__float_as_uint(m),__float_as_uint(m),false,false);
  return max2f(__uint_as_float(rr[0]),__uint_as_float(rr[1]));
}
__device__ __forceinline__ void pv(f32x16*o,int vb,bf16x8 pa0,bf16x8 pa1,bf16x8 pa2,bf16x8 pa3){
  #pragma unroll
  for(int d0=0;d0<2;++d0){s16x4 lo[4],hi[4];
    #pragma unroll
    for(int ks=0;ks<4;++ks){
      asm volatile("ds_read_b64_tr_b16 %0,%1 offset:%c2":"=&v"(lo[ks]):"v"(vb),"i"(d0*4096+ks*1024):"memory");
      asm volatile("ds_read_b64_tr_b16 %0,%1 offset:%c2":"=&v"(hi[ks]):"v"(vb),"i"(d0*4096+ks*1024+512):"memory");}
    asm volatile("s_waitcnt lgkmcnt(0)":::"memory");SBAR();
    #define PK(k) (bf16x8){lo[k][0],lo[k][1],lo[k][2],lo[k][3],hi[k][0],hi[k][1],hi[k][2],hi[k][3]}
    o[d0]=__builtin_amdgcn_mfma_f32_32x32x16_bf16(pa0,PK(0),o[d0],0,0,0);
    o[d0]=__builtin_amdgcn_mfma_f32_32x32x16_bf16(pa1,PK(1),o[d0],0,0,0);
    o[d0]=__builtin_amdgcn_mfma_f32_32x32x16_bf16(pa2,PK(2),o[d0],0,0,0);
    o[d0]=__builtin_amdgcn_mfma_f32_32x32x16_bf16(pa3,PK(3),o[d0],0,0,0);
    #undef PK
  }
}

#ifndef ATTN_STORE16
#define ATTN_STORE16(p,v) (*(u32x4*)(p)=(v))
#endif
template<int THRL> __device__ __forceinline__ void attn_unit(int b,int h,int hv,int qb,const bf16*Q,const bf16*__restrict__ K,const bf16*__restrict__ V,bf16*O,char*shm){
  const int tid=threadIdx.x,lane=tid&63,r32=lane&31,hi=lane>>5; const int wid=__builtin_amdgcn_readfirstlane(tid>>6);
  const long rowbase=(long)b*SEQ; const int q0=qb*QB;
  const bf16*Qw=Q+(rowbase+q0+wid*QBLK)*DM+h*D;
  const bf16*Kh=K+rowbase*DM+h*D,*Vh=V+rowbase*DM+hv*D;
  const unsigned lds0=(unsigned)(uintptr_t)shm;
  float*wsf=(float*)(shm+LDS_WS)+wid*64;
  const bf16*ksrc=Kh+(long)lane*DM+wid*8;
  const bf16*vsrc=Vh+(long)(16*(wid&3)+(lane>>2))*DM+(wid>>2)*32+(lane&3)*8;
  const unsigned kdst=lds0+LDS_K+wid*1024, vdst=lds0+LDS_V+wid*1024;
  #define DMA_K(t,slot) glds16(ksrc+(long)(t)*KVBLK*DM,(unsigned)__builtin_amdgcn_readfirstlane(kdst+(slot)))
  #define DMA_V(t,slot) glds16(vsrc+(long)(t)*KVBLK*DM,(unsigned)__builtin_amdgcn_readfirstlane(vdst+(slot)))
  const int vb0=(int)(lds0+LDS_V)+((lane>>4)&1)*32+(lane&3)*8+(4*hi+((lane&15)>>2))*64;
  const char*Kbase=shm+LDS_K; bf16x8 kf[8];
  const lds_cptr shm3=(lds_cptr)shm; const lds_cptr kp0=shm3+LDS_K+hi*1024+r32*16; const lds_cptr vp0=shm3+LDS_V+((lane>>4)&1)*32+(lane&3)*8+(4*hi+((lane&15)>>2))*64;
  const int NT=(q0+QB)/KVBLK;
  DMA_K(0,0);DMA_V(0,0);DMA_K(1,SLOTB);
  bf16x8 qr[4];
  #pragma unroll
  for(int d0=0;d0<4;++d0)qr[d0]=*reinterpret_cast<const bf16x8*>(&Qw[(long)r32*DM+d0*16+hi*8]);
  float mhat=0.f,l_reg=0.f;f32x16 o[2];o[0]=f32x16{};o[1]=f32x16{};f32x16 negm=f32x16{};asm volatile("":"+v"(negm));
  const int qrel=wid*QBLK+r32;
  #define CMASK(P0,P1,t) do{int jb_=(t)-(NT-4); if(jb_>=0)cmask(P0,P1,jb_,qrel,hi);}while(0)
  bool resc=false;
  #define START(P0,P1) do{ const float rm=rowmax(P0,P1); resc=false; \
    { const float dl=rm; mhat=fadd_s(mhat,dl); \
      _Pragma("unroll") for(int r=0;r<16;++r){P0[r]=fsub_s(P0[r],dl);P1[r]=fsub_s(P1[r],dl);} \
      _Pragma("unroll") for(int r=0;r<16;++r)negm[r]=-mhat; asm volatile("":"+v"(negm)); } \
    _Pragma("unroll") for(int r=0;r<16;++r)P0[r]=__builtin_amdgcn_exp2f(P0[r]); }while(0)
  #define RESC() do{ if(resc){ asm volatile("s_waitcnt lgkmcnt(0)":::"memory"); \
      _Pragma("unroll") for(int d_=0;d_<2;++d_) _Pragma("unroll") for(int r=0;r<16;++r)o[d_][r]*=wsf[crow(r,hi)]; } }while(0)
  f32x16 pA0,pA1,pB0,pB1;
  int sl_prev=0,sl_cur=0,sl_next=SLOTB;
  #define ROT() do{sl_prev=sl_cur;sl_cur=sl_next;sl_next=(sl_next==(NSLOT-1)*SLOTB)?0:sl_next+SLOTB;}while(0)
  DMA_K(2,2*SLOTB);
  WAIT_BAR(3);
  qkt(pA0,pA1,Kbase,qr,negm,r32,hi);asm volatile("s_nop 15\n\ts_nop 7":"+v"(pA0),"+v"(pA1));CMASK(pA0,pA1,0);
  START(pA0,pA1);
  _Pragma("unroll") for(int r=0;r<16;++r)pA1[r]=__builtin_amdgcn_exp2f(pA1[r]);
  WAIT_BAR(0);
  DMA_K(3,0);DMA_V(1,SLOTB);
  ROT();
  kload8(kf,kp0+sl_cur);
  WAIT_BAR(2);
  s16x4 vlo[8],vhi[8]; u32x4 pw0,pw1,pw2,pw3;
  #define PKW(P,B) cvtpk_s(P[B],P[B+1])
  #define PAF(k) __builtin_bit_cast(bf16x8,pw##k)
  #define VFR(i) (bf16x8){vlo[i][0],vlo[i][1],vlo[i][2],vlo[i][3],vhi[i][0],vhi[i][1],vhi[i][2],vhi[i][3]}
  #define PIN(x) asm volatile("":"+v"(x))
  #define MX3(a,b,c) __builtin_fmaxf(__builtin_fmaxf((a),(b)),(c))
  #define GAPA(MF,A0,A1,A2,A3,W0,W1,PW) do{ MF; sacc+=A0; sacc+=A1; sacc+=A2; sacc+=A3; PIN(sacc); W0; W1; PIN(PW); SBAR(); }while(0)
  #define EX(v) __builtin_amdgcn_exp2f(v)
  #define GAPB(MF,X,B) do{ MF; X[B]=EX(X[B]); X[B+1]=EX(X[B+1]); X[B+2]=EX(X[B+2]); X[B+3]=EX(X[B+3]); PIN(X); SBAR(); }while(0)
  #define VRD(i) do{ vlo[i]=vtr(vp_+(((i)>>2)*4096+((i)&3)*1024)); vhi[i]=vtr(vp_+(((i)>>2)*4096+((i)&3)*1024+512)); }while(0)
  #define KRD(G,j) do{ if(G){ kload2(kf,kp0+sl_next,j); SBAR(); } }while(0)
  #define STEP(C0,C1,P0,P1,t,GK,GV,GL) do{ SBAR(); \
    const lds_cptr vp_=vp0+sl_prev; \
    VRD(0); SBAR(); float sacc=(P0[0]+P0[1]); \
    GAPA(C0=__builtin_amdgcn_mfma_f32_32x32x16_bf16(kf[0],qr[0],negm,0,0,0), P0[2],P0[3],P0[4],P0[5],     pw0[0]=PKW(P0,0), pw0[1]=PKW(P0,2), pw0); \
    VRD(4); SBAR(); GAPA(C1=__builtin_amdgcn_mfma_f32_32x32x16_bf16(kf[1],qr[0],negm,0,0,0), P0[6],P0[7],P0[8],P0[9],     pw0[2]=PKW(P0,4), pw0[3]=PKW(P0,6), pw0); \
    VRD(1); SBAR(); GAPA(C0=__builtin_amdgcn_mfma_f32_32x32x16_bf16(kf[2],qr[1],C0,0,0,0),   P0[10],P0[11],P0[12],P0[13], pw1[0]=PKW(P0,8), pw1[1]=PKW(P0,10), pw1); \
    VRD(5); SBAR(); GAPA(C1=__builtin_amdgcn_mfma_f32_32x32x16_bf16(kf[3],qr[1],C1,0,0,0),   P0[14],P0[15],P1[0],P1[1],   pw1[2]=PKW(P0,12),pw1[3]=PKW(P0,14), pw1); \
    VRD(2); SBAR(); GAPA(C0=__builtin_amdgcn_mfma_f32_32x32x16_bf16(kf[4],qr[2],C0,0,0,0),   P1[2],P1[3],P1[4],P1[5],     pw2[0]=PKW(P1,0), pw2[1]=PKW(P1,2), pw2); \
    VRD(6); SBAR(); GAPA(C1=__builtin_amdgcn_mfma_f32_32x32x16_bf16(kf[5],qr[2],C1,0,0,0),   P1[6],P1[7],P1[8],P1[9],     pw2[2]=PKW(P1,4), pw2[3]=PKW(P1,6), pw2); \
    VRD(3); SBAR(); GAPA(C0=__builtin_amdgcn_mfma_f32_32x32x16_bf16(kf[6],qr[3],C0,0,0,0),   P1[10],P1[11],P1[12],P1[13], pw3[0]=PKW(P1,8), pw3[1]=PKW(P1,10), pw3); \
    VRD(7); SBAR(); GAPA(C1=__builtin_amdgcn_mfma_f32_32x32x16_bf16(kf[7],qr[3],C1,0,0,0),   P1[14],P1[15],0.f,0.f,       pw3[2]=PKW(P1,12),pw3[3]=PKW(P1,14), pw3); \
    l_reg+=sacc; \
    if(GK){DMA_K((t)+3,sl_cur);} if(GV){DMA_V((t)+1,sl_next);} \
    CMASK(C0,C1,t); \
    { float a=MX3(C0[0],C0[1],C1[0]),b=MX3(C0[2],C0[3],C1[1]); a=MX3(a,C1[2],C1[3]); \
      _Pragma("unroll") for(int r=4;r<16;r+=4){a=MX3(a,C0[r],C0[r+1]);b=MX3(b,C0[r+2],C0[r+3]);a=MX3(a,C1[r],C1[r+1]);b=MX3(b,C1[r+2],C1[r+3]);} \
      float rm=__builtin_fmaxf(a,b); { auto rr=__builtin_amdgcn_permlane32_swap(__float_as_uint(rm),__float_as_uint(rm),false,false); rm=__builtin_fmaxf(__uint_as_float(rr[0]),__uint_as_float(rr[1])); } \
      resc=false; \
      if(__builtin_expect(__any(rm>(float)THRL),0)){ const float dl=__builtin_fmaxf(rm,0.f); mhat+=dl; \
        _Pragma("unroll") for(int r=0;r<16;++r){C0[r]-=dl;C1[r]-=dl;} \
        _Pragma("unroll") for(int r=0;r<16;++r)negm[r]=-mhat; asm volatile("":"+v"(negm)); \
        const float f=__builtin_amdgcn_exp2f(-dl); l_reg*=f; if(hi==0)wsf[r32]=f; resc=true; } } \
    SBAR(); \
    GAPB(o[0]=__builtin_amdgcn_mfma_f32_32x32x16_bf16(PAF(0),VFR(0),o[0],0,0,0), C0,0); \
    GAPB(o[1]=__builtin_amdgcn_mfma_f32_32x32x16_bf16(PAF(0),VFR(4),o[1],0,0,0), C0,4); \
    KRD(GL,0); GAPB(o[0]=__builtin_amdgcn_mfma_f32_32x32x16_bf16(PAF(1),VFR(1),o[0],0,0,0), C0,8); \
    KRD(GL,1); GAPB(o[1]=__builtin_amdgcn_mfma_f32_32x32x16_bf16(PAF(1),VFR(5),o[1],0,0,0), C0,12); \
    KRD(GL,2); GAPB(o[0]=__builtin_amdgcn_mfma_f32_32x32x16_bf16(PAF(2),VFR(2),o[0],0,0,0), C1,0); \
    KRD(GL,3); GAPB(o[1]=__builtin_amdgcn_mfma_f32_32x32x16_bf16(PAF(2),VFR(6),o[1],0,0,0), C1,4); \
    GAPB(o[0]=__builtin_amdgcn_mfma_f32_32x32x16_bf16(PAF(3),VFR(3),o[0],0,0,0), C1,8); \
    GAPB(o[1]=__builtin_amdgcn_mfma_f32_32x32x16_bf16(PAF(3),VFR(7),o[1],0,0,0), C1,12); \
    }while(0)
  int t=1;
  #undef CMASK
  #define CMASK(P0,P1,t) do{}while(0)
  for(;t+5<NT;t+=2){
    STEP(pB0,pB1,pA0,pA1,t,true,true,true);     WAIT_BAR(2); RESC(); ROT();
    STEP(pA0,pA1,pB0,pB1,t+1,true,true,true);   WAIT_BAR(2); RESC(); ROT();
  }
  #undef CMASK
  #define CMASK(P0,P1,t) do{int jb_=(t)-(NT-4); if(jb_>=0)cmask(P0,P1,jb_,qrel,hi);}while(0)
  #define ENDW(tt) do{ if((tt)+3<NT){WAIT_BAR(2);} else if((tt)+2<NT){WAIT_BAR(1);} else {WAIT_BAR(0);} }while(0)
  for(;t+1<NT;t+=2){
    STEP(pB0,pB1,pA0,pA1,t,(t+3<NT),(t+1<NT),(t+1<NT));       ENDW(t);   RESC(); ROT();
    STEP(pA0,pA1,pB0,pB1,t+1,(t+4<NT),(t+2<NT),(t+2<NT));     ENDW(t+1); RESC(); ROT();
  }
  STEP(pB0,pB1,pA0,pA1,NT-1,false,false,false); RESC();
  { float sacc=pB0[0]+pB0[1]; _Pragma("unroll") for(int r=2;r<16;++r)sacc+=pB0[r]; _Pragma("unroll") for(int r=0;r<16;++r)sacc+=pB1[r]; l_reg+=sacc;
    pw0=(u32x4){PKW(pB0,0),PKW(pB0,2),PKW(pB0,4),PKW(pB0,6)};pw1=(u32x4){PKW(pB0,8),PKW(pB0,10),PKW(pB0,12),PKW(pB0,14)};pw2=(u32x4){PKW(pB1,0),PKW(pB1,2),PKW(pB1,4),PKW(pB1,6)};pw3=(u32x4){PKW(pB1,8),PKW(pB1,10),PKW(pB1,12),PKW(pB1,14)};
    SBAR(); pv(o,vb0+sl_cur,PAF(0),PAF(1),PAF(2),PAF(3)); }
  #undef PKW
  #undef PAF
  #undef VFR
  #undef PIN
  #undef MX3
  #undef GAPA
  #undef GAPB
  #undef EX
  #undef VRD
  #undef KRD
  #undef STEP
  #undef ENDW
  {auto rr=__builtin_amdgcn_permlane32_swap(__float_as_uint(l_reg),__float_as_uint(l_reg),false,false);l_reg=__uint_as_float(rr[0])+__uint_as_float(rr[1]);}
  if(hi==0)wsf[32+r32]=l_reg;asm volatile("s_waitcnt lgkmcnt(0)":::"memory");
  float rli[16];
  #pragma unroll
  for(int r=0;r<16;++r)rli[r]=__builtin_amdgcn_rcpf(wsf[32+crow(r,hi)]);
  bf16*Ow=O+(rowbase+q0+wid*QBLK)*DM+hv*D;
  { bf16*stg=(bf16*)(shm+LDS_OST)+wid*2048;
    #pragma unroll
    for(int r=0;r<16;++r){const int orow=crow(r,hi);
      #pragma unroll
      for(int d0=0;d0<2;++d0)stg[orow*64+d0*32+r32]=__float2bfloat16(o[d0][r]*rli[r]);}
    asm volatile("s_waitcnt lgkmcnt(0)":::"memory");
    #pragma unroll
    for(int i=0;i<4;++i){const int row=i*8+(lane>>3),ch=lane&7; const u32x4 v=*(const u32x4*)(stg+row*64+ch*8); ATTN_STORE16(Ow+(long)row*DM+ch*8,v);} }
  asm volatile("s_waitcnt lgkmcnt(0)\n\ts_barrier":::"memory");
  #undef DMA_K
  #undef DMA_V
  #undef CMASK
  #undef START
  #undef RESC
  #undef ROT
}
constexpr int ATTN_LDS_BYTES=LDS_BYTES;
#undef SBAR
#undef WAIT_BAR
}
namespace swa {
constexpr int D = 128; constexpr float THR = 8.f; constexpr bool WSKIP = true;
constexpr float SCALE = 0.08838834764831845f;
constexpr int NW = 8, QBLK = 32, KVBLK = 64, QB = NW * QBLK;
constexpr int SHM_V = KVBLK * D * 2, SHM_K = KVBLK * D * 2;
constexpr int LDS_BYTES = 2 * SHM_V + 2 * SHM_K + NW * 64 * 4;
using bf16 = __hip_bfloat16;
typedef short bf16x8 __attribute__((ext_vector_type(8)));
typedef short s16x4 __attribute__((ext_vector_type(4)));
typedef float f32x16 __attribute__((ext_vector_type(16)));
typedef float f32x4 __attribute__((ext_vector_type(4)));
typedef unsigned u32x4 __attribute__((ext_vector_type(4)));
template <class A, class Bt> struct same_t { static constexpr bool v = false; };
template <class A> struct same_t<A, A> { static constexpr bool v = true; };

#define KSWZ(row, colB) ((row) * 256 + ((colB) ^ (((row) & 7) << 4)))
#define SBAR() __builtin_amdgcn_sched_barrier(0)
__device__ __forceinline__ int v_st(int k, int c) { const int kk = (k & ~0xC) | ((k & 4) << 1) | ((k & 8) >> 1); return ((kk >> 3) * 4 + (c >> 5)) * 512 + ((kk & 7) * 32 + (c & 31)) * 2; }
__device__ __forceinline__ int v_rd_base(int lane) { return ((lane & 3) << 3) | (((lane >> 2) & 3) << 6) | (((lane >> 4) & 1) << 5) | (((lane >> 5) & 1) << 8); }
constexpr int v_rd_off(int d0, int ks, int half) { return d0 * 512 + ks * 4096 + half * 2048; }
__device__ __forceinline__ int crow(int r, int hi) { return (r & 3) + 8 * (r >> 2) + 4 * hi; }
__device__ __forceinline__ unsigned cvtpk(float lo, float hi) {
    unsigned r; asm volatile("v_cvt_pk_bf16_f32 %0, %1, %2" : "=v"(r) : "v"(lo), "v"(hi)); return r;
}
__device__ __forceinline__ bf16x8 pack8(f32x4 a, f32x4 b) {
    u32x4 w = {cvtpk(a[0], a[1]), cvtpk(a[2], a[3]), cvtpk(b[0], b[1]), cvtpk(b[2], b[3])};
    return *reinterpret_cast<bf16x8*>(&w);
}
template <class T> __device__ __forceinline__ bf16x8 load8(const T* p) {
    if constexpr (same_t<T, float>::v) { return pack8(*(const f32x4*)p, *(const f32x4*)(p + 4)); }
    else { return *reinterpret_cast<const bf16x8*>(p); }
}
__device__ __forceinline__ void mask_tile(f32x16& p0, f32x16& p1, int dq, unsigned W) {
    const float NEG = -__builtin_inff();
#pragma unroll
    for (int r = 0; r < 16; ++r) {
        const int c = (r & 3) + 8 * (r >> 2);
        if ((unsigned)(dq - c) >= W) p0[r] = NEG;
        if ((unsigned)(dq - c - 32) >= W) p1[r] = NEG;
    }
}
__device__ __forceinline__ void partialSM(f32x16& p0, f32x16& p1, float& m_reg, float& mn, float& alpha) {
    float pmax = p0[0]; for (int r = 1; r < 16; ++r) pmax = fmaxf(pmax, p0[r]); for (int r = 0; r < 16; ++r) pmax = fmaxf(pmax, p1[r]);
    { auto rr = __builtin_amdgcn_permlane32_swap(__float_as_uint(pmax), __float_as_uint(pmax), false, false);
      pmax = fmaxf(__uint_as_float(rr[0]), __uint_as_float(rr[1])); }
    constexpr float C2 = 1.4426950408889634f * SCALE;
    if (__builtin_expect(__all((pmax - m_reg) * SCALE <= THR), 1)) { mn = m_reg; alpha = 1.f; }
    else { mn = fmaxf(m_reg, pmax); alpha = __builtin_amdgcn_exp2f((m_reg - mn) * C2); m_reg = mn; }
    const float mnL = -mn * C2;
    for (int r = 0; r < 16; ++r) p0[r] = fmaf(p0[r], C2, mnL); for (int r = 0; r < 16; ++r) p1[r] = fmaf(p1[r], C2, mnL);
    for (int r = 0; r < 16; ++r) p0[r] = __builtin_amdgcn_exp2f(p0[r]);
}
__device__ __forceinline__ void finishSM(f32x16& p0, f32x16& p1, float alpha, float& l_reg, bf16x8& pa0, bf16x8& pa1, bf16x8& pa2, bf16x8& pa3) {
    for (int r = 0; r < 16; ++r) p1[r] = __builtin_amdgcn_exp2f(p1[r]);
    float ps = 0; for (int r = 0; r < 16; ++r) ps += p0[r]; for (int r = 0; r < 16; ++r) ps += p1[r];
    { auto rr = __builtin_amdgcn_permlane32_swap(__float_as_uint(ps), __float_as_uint(ps), false, false);
      ps = __uint_as_float(rr[0]) + __uint_as_float(rr[1]); }
    l_reg = l_reg * alpha + ps;
#define PK4(P, B_, OUT) do { unsigned a0 = cvtpk(P[B_+0], P[B_+1]), a1 = cvtpk(P[B_+2], P[B_+3]);                          \
        unsigned b0 = cvtpk(P[B_+4], P[B_+5]), b1 = cvtpk(P[B_+6], P[B_+7]);                                             \
        auto r0 = __builtin_amdgcn_permlane32_swap(a0, b0, false, false); auto r1 = __builtin_amdgcn_permlane32_swap(a1, b1, false, false); \
        u32x4 w = {r0[0], r1[0], r0[1], r1[1]}; OUT = *reinterpret_cast<bf16x8*>(&w); } while (0)
    PK4(p0, 0, pa0); PK4(p0, 8, pa1); PK4(p1, 0, pa2); PK4(p1, 8, pa3);
#undef PK4
}
template <int KB, bool SK>
__device__ __forceinline__ void qkt(f32x16& p0, f32x16& p1, const char* K_lds, int r32, int hi, const bf16x8* qr, bool act) {
    if (SK && !act) { const float NEG = -__builtin_inff();
#pragma unroll
        for (int r = 0; r < 16; ++r) { p0[r] = NEG; p1[r] = NEG; } return; }
    p0 = f32x16{}; p1 = f32x16{};
    const char* kb[4];
#pragma unroll
    for (int dd = 0; dd < 4; ++dd) kb[dd] = K_lds + KB * SHM_K + KSWZ(r32, (dd * 16 + hi * 8) * 2);
#pragma unroll
    for (int d0 = 0; d0 < 8; ++d0) { const char* a = kb[d0 & 3] + (d0 >> 2) * 128;
        bf16x8 b0 = *reinterpret_cast<const bf16x8*>(a);
        bf16x8 b1 = *reinterpret_cast<const bf16x8*>(a + 32 * 256);
        p0 = __builtin_amdgcn_mfma_f32_32x32x16_bf16(b0, qr[d0], p0, 0, 0, 0);
        p1 = __builtin_amdgcn_mfma_f32_32x32x16_bf16(b1, qr[d0], p1, 0, 0, 0); }
}
template <int VB, bool SK>
__device__ __forceinline__ void pv_tile(f32x16* o, int vb0, bf16x8 pa0, bf16x8 pa1, bf16x8 pa2, bf16x8 pa3, bool act) {
    if (SK && !act) return;
#define TRRD(dst, off) asm volatile("ds_read_b64_tr_b16 %0, %1 offset:%2" : "=&v"(dst) : "v"(vb0), "i"(off) : "memory")
#define PV_D0(d0) do { s16x4 l0, l1, l2, l3, h0, h1, h2, h3; constexpr int b_ = VB * SHM_V + v_rd_off(d0, 0, 0);     \
        TRRD(l0, b_); TRRD(h0, b_ + 2048); TRRD(l1, b_ + 4096); TRRD(h1, b_ + 6144); TRRD(l2, b_ + 8192); TRRD(h2, b_ + 10240); TRRD(l3, b_ + 12288); TRRD(h3, b_ + 14336); \
        asm volatile("s_waitcnt lgkmcnt(0)" ::: "memory"); SBAR();                 \
        o[d0] = __builtin_amdgcn_mfma_f32_32x32x16_bf16(pa0, (bf16x8){l0[0], l0[1], l0[2], l0[3], h0[0], h0[1], h0[2], h0[3]}, o[d0], 0, 0, 0);   \
        o[d0] = __builtin_amdgcn_mfma_f32_32x32x16_bf16(pa1, (bf16x8){l1[0], l1[1], l1[2], l1[3], h1[0], h1[1], h1[2], h1[3]}, o[d0], 0, 0, 0);   \
        o[d0] = __builtin_amdgcn_mfma_f32_32x32x16_bf16(pa2, (bf16x8){l2[0], l2[1], l2[2], l2[3], h2[0], h2[1], h2[2], h2[3]}, o[d0], 0, 0, 0);   \
        o[d0] = __builtin_amdgcn_mfma_f32_32x32x16_bf16(pa3, (bf16x8){l3[0], l3[1], l3[2], l3[3], h3[0], h3[1], h3[2], h3[3]}, o[d0], 0, 0, 0); } while (0)
    PV_D0(0); PV_D0(1); PV_D0(2); PV_D0(3);
#undef PV_D0
#undef TRRD
}

template <class TIn, class TOut> struct BlockRef { const TIn* Q; const TIn* K; const TIn* V; TOut* O; float* LSE; int P0; int rs; int ls; };
template <class TIn> struct Seam {
    bf16x8 qr[8];
    bf16x8 st_v0, st_v1, st_k0, st_k1; f32x4 sf0, sf1, sf2, sf3;
    f32x4 tq[16];
};
__device__ __forceinline__ int swa_jlo(int P0, int W) { const int lowk = P0 - W + 1; return lowk > 0 ? lowk / KVBLK : 0; }
#define ROW(p, k0, rr, RS) ((p) + ((unsigned)((k0) + (rr)) * (unsigned)(RS) + (unsigned)sc))
#define VMW() asm volatile("s_waitcnt vmcnt(0)" ::: "memory")
#define VMWN(n) asm volatile("s_waitcnt vmcnt(%0)" :: "i"(n) : "memory")
#define SLOAD_H(Kp, Vp, k0, RS) do { S.st_v0 = load8<TIn>(ROW(Vp, k0, sr, RS)); S.st_v1 = load8<TIn>(ROW(Vp, k0, 32 + sr, RS));              \
                         S.st_k0 = load8<TIn>(ROW(Kp, k0, sr, RS)); S.st_k1 = load8<TIn>(ROW(Kp, k0, 32 + sr, RS)); } while (0)
#define SWRITE_HK(bf) do { *(bf16x8*)(K_lds + (bf) * SHM_K + kws) = S.st_k0; *(bf16x8*)(K_lds + (bf) * SHM_K + kws + 32 * 256) = S.st_k1; } while (0)
#define SWRITE_HV(bf) do { *(bf16x8*)(V_lds + (bf) * SHM_V + vst0) = S.st_v0; *(bf16x8*)(V_lds + (bf) * SHM_V + vst1) = S.st_v1; } while (0)
#define SWRITE_H(bf) do { SWRITE_HV(bf); SWRITE_HK(bf); } while (0)
#define SLOAD_F(p, k0) do { S.sf0 = *(const f32x4*)ROW(p, k0, sr, D); S.sf1 = *(const f32x4*)(ROW(p, k0, sr, D) + 4);                \
                            S.sf2 = *(const f32x4*)ROW(p, k0, 32 + sr, D); S.sf3 = *(const f32x4*)(ROW(p, k0, 32 + sr, D) + 4); } while (0)
#define SWRITE_KF(bf) do { *(bf16x8*)(K_lds + (bf) * SHM_K + kws) = pack8(S.sf0, S.sf1); *(bf16x8*)(K_lds + (bf) * SHM_K + kws + 32 * 256) = pack8(S.sf2, S.sf3); } while (0)
#define SWRITE_VF(bf) do { *(bf16x8*)(V_lds + (bf) * SHM_V + vst0) = pack8(S.sf0, S.sf1); *(bf16x8*)(V_lds + (bf) * SHM_V + vst1) = pack8(S.sf2, S.sf3); } while (0)
template <class TIn, class TOut>
__device__ __forceinline__ void causal_swa_prime(const BlockRef<TIn, TOut>& cur, int W, char* lds, Seam<TIn>& S) {
    constexpr bool F32 = same_t<TIn, float>::v;
    const int tid = threadIdx.x, wid = __builtin_amdgcn_readfirstlane(tid >> 6), lane = tid & 63, r32 = lane & 31, hi = lane >> 5;
    const int sr = tid >> 4, sc = (tid & 15) * 8, kws = KSWZ(sr, sc * 2); char* K_lds = lds + 2 * SHM_V;
    const int kb0 = swa_jlo(cur.P0, W) * KVBLK;
    for (int d0 = 0; d0 < 8; ++d0) S.qr[d0] = load8<TIn>(cur.Q + (unsigned)(wid * QBLK + r32) * (unsigned)cur.rs + d0 * 16 + hi * 8);
    if constexpr (F32) { SLOAD_F((const float*)cur.K, kb0); VMW(); SWRITE_KF(0); SBAR(); SLOAD_F((const float*)cur.V, kb0); }
    else { SLOAD_H(cur.K, cur.V, kb0, cur.rs); VMW(); SWRITE_HK(0); }
    __syncthreads();
}
template <class TIn, class TOut>
__device__ __forceinline__ void causal_swa_block(const BlockRef<TIn, TOut>& cur, const BlockRef<TIn, TOut>& nxt, int skv, int W, char* lds, Seam<TIn>& S) {
    constexpr bool F32 = same_t<TIn, float>::v;
    const int tid = threadIdx.x, wid = __builtin_amdgcn_readfirstlane(tid >> 6), lane = tid & 63, r32 = lane & 31, hi = lane >> 5;
    const int j_lo = swa_jlo(cur.P0, W);
    int j_hi = (cur.P0 + QB - 1) / KVBLK + 1; if (j_hi > skv / KVBLK) j_hi = skv / KVBLK;
    const int NT = j_hi - j_lo;
    const int kbn = swa_jlo(nxt.P0, W) * KVBLK;
    const int qlo = cur.P0 + wid * QBLK, qm = qlo + r32 - 4 * hi;
    char* V_lds = lds; char* K_lds = lds + 2 * SHM_V;
    float* ws = (float*)(lds + 2 * SHM_V + 2 * SHM_K) + wid * 64; float* li_l = ws, * al_l = ws + 32;
    float m_reg = -1e30f, l_reg = 0; f32x16 o[4] = {};
    const int sr = tid >> 4, sc = (tid & 15) * 8, vst0 = v_st(sr, sc), vst1 = v_st(32 + sr, sc), kws = KSWZ(sr, sc * 2);
    const int vb0 = (int)(uintptr_t)V_lds + v_rd_base(lane);
    const TIn* Kh = cur.K; const TIn* Vh = cur.V;
#define RESC(a) do { if (__any((a) < 1.f)) { if (hi == 0) al_l[r32] = (a); asm volatile("s_waitcnt lgkmcnt(0)" ::: "memory");              \
                     for (int d_ = 0; d_ < 4; ++d_) for (int r = 0; r < 16; ++r) o[d_][r] *= al_l[crow(r, hi)]; } } while (0)
#define KBASE(t) ((j_lo + (t)) * KVBLK)
#define ACT(t) (KBASE(t) <= qlo + QBLK - 1 && KBASE(t) + KVBLK - 1 >= qlo - W + 1)
#define MASKT(P0_, P1_, t) do { const int kb_ = KBASE(t); if ((!SK || ACT(t)) && (kb_ + KVBLK - 1 > qlo || kb_ <= qlo + QBLK - 1 - W)) mask_tile(P0_, P1_, qm - kb_, (unsigned)W); } while (0)
    constexpr int NQL = F32 ? 16 : 8;
    constexpr bool SK = WSKIP && !F32;
#define SEAM_K0() do { VMWN(NQL); if constexpr (F32) { SWRITE_KF(0); SBAR(); SLOAD_F((const float*)nxt.V, kbn); } else { SWRITE_HK(0); } SBAR(); } while (0)
    f32x16 pA0, pA1, pB0, pB1; float mnA, mnB, alA, alB; bf16x8 pa0, pa1, pa2, pa3;
    if constexpr (F32) { VMW(); SWRITE_VF(0); SBAR(); } else { SWRITE_HV(0); SBAR(); }
    if (NT > 1) { if constexpr (F32) SLOAD_F((const float*)Kh, KBASE(1)); else SLOAD_H(Kh, Vh, KBASE(1), cur.rs); }
    SBAR(); qkt<0, SK>(pA0, pA1, K_lds, r32, hi, S.qr, ACT(0));
    if constexpr (F32) { if (NT > 1) { VMW(); SWRITE_KF(1); SBAR(); SLOAD_F((const float*)Vh, KBASE(1)); } }
    MASKT(pA0, pA1, 0); partialSM(pA0, pA1, m_reg, mnA, alA);
    if (NT > 1) { VMW(); if constexpr (F32) { SWRITE_VF(1); SBAR(); if (NT > 2) SLOAD_F((const float*)Kh, KBASE(2)); } else SWRITE_H(1); }
    __syncthreads();
#define HALF_STEP(PX0, PX1, mnX, alX, PY0, PY1, alY, t, KB, VB, SB) do {                                                      \
        SBAR(); qkt<KB, SK>(PX0, PX1, K_lds, r32, hi, S.qr, ACT(t));                                             \
        finishSM(PY0, PY1, alY, l_reg, pa0, pa1, pa2, pa3); SBAR();                                                           \
        if ((t) + 1 < NT) { if constexpr (F32) { VMW(); SWRITE_KF(SB); SBAR(); SLOAD_F((const float*)Vh, KBASE((t) + 1)); }  \
                            else { SLOAD_H(Kh, Vh, KBASE((t) + 1), cur.rs); } SBAR(); }                                               \
        pv_tile<VB, SK>(o, vb0, pa0, pa1, pa2, pa3, ACT((t) - 1)); MASKT(PX0, PX1, (t)); partialSM(PX0, PX1, m_reg, mnX, alX);                                        \
        __syncthreads();                                                                                                      \
        if ((t) + 1 < NT) { VMW(); if constexpr (F32) { SWRITE_VF(SB); SBAR(); if ((t) + 2 < NT) SLOAD_F((const float*)Kh, KBASE((t) + 2)); } \
                            else { SWRITE_H(SB); } }                                                                          \
        RESC(alX); __syncthreads(); } while (0)
    for (int t = 1; t + 1 < NT; t += 2) {
        HALF_STEP(pB0, pB1, mnB, alB, pA0, pA1, alA, t, 1, 0, 0);
        HALF_STEP(pA0, pA1, mnA, alA, pB0, pB1, alB, t + 1, 0, 1, 1);
    }
    const bool even = (NT & 1) == 0;
    if (even) { SBAR(); qkt<1, SK>(pB0, pB1, K_lds, r32, hi, S.qr, ACT(NT - 1)); SBAR(); }
#define QROW(e) (nxt.Q + (size_t)(wid * QBLK + r32) * D + ((e) >> 1) * 16 + hi * 8 + ((e) & 1) * 4)
    if constexpr (F32) { SLOAD_F((const float*)nxt.K, kbn); SBAR();
#pragma unroll
        for (int e = 0; e < 8; ++e) S.tq[e] = *(const f32x4*)QROW(e); }
    else { SLOAD_H(nxt.K, nxt.V, kbn, nxt.rs); SBAR();
#pragma unroll
        for (int d0 = 0; d0 < 8; ++d0) S.qr[d0] = load8<TIn>(nxt.Q + (unsigned)(wid * QBLK + r32) * (unsigned)nxt.rs + d0 * 16 + hi * 8); }
    SBAR();
    finishSM(pA0, pA1, alA, l_reg, pa0, pa1, pa2, pa3); SBAR();
    if constexpr (F32) {
#pragma unroll
        for (int e = 8; e < 16; ++e) S.tq[e] = *(const f32x4*)QROW(e); SBAR(); }
#undef QROW
    pv_tile<0, SK>(o, vb0, pa0, pa1, pa2, pa3, ACT(even ? NT - 2 : NT - 1));
    if (even) { MASKT(pB0, pB1, NT - 1); partialSM(pB0, pB1, m_reg, mnB, alB); __syncthreads(); RESC(alB);
        finishSM(pB0, pB1, alB, l_reg, pa0, pa1, pa2, pa3); SBAR(); pv_tile<1, SK>(o, vb0, pa0, pa1, pa2, pa3, ACT(NT - 1)); }
    SBAR(); SEAM_K0();
    if (hi == 0) li_l[r32] = l_reg; asm volatile("s_waitcnt lgkmcnt(0)" ::: "memory");
    float rli[16];
#pragma unroll
    for (int r = 0; r < 16; ++r) rli[r] = __builtin_amdgcn_rcpf(li_l[crow(r, hi)]);
    TOut* Ow = cur.O + (unsigned)(wid * QBLK) * (unsigned)cur.rs;
    if (hi == 0) cur.LSE[(unsigned)(wid * QBLK + r32) * (unsigned)cur.ls] = m_reg * SCALE + __logf(l_reg);
#pragma unroll
    for (int r = 0; r < 16; ++r) { const int orow = crow(r, hi);
#pragma unroll
        for (int d0 = 0; d0 < 4; ++d0) { const float v = o[d0][r] * rli[r];
            if constexpr (same_t<TOut, float>::v) { Ow[(unsigned)orow * (unsigned)cur.rs + d0 * 32 + r32] = v; }
            else { const float vn = __shfl_xor(v, 1);
                   if ((r32 & 1) == 0) *(unsigned*)(Ow + (unsigned)orow * (unsigned)cur.rs + d0 * 32 + r32) = cvtpk(v, vn); } } }
    if constexpr (F32) {
#pragma unroll
        for (int d0 = 0; d0 < 8; ++d0) S.qr[d0] = pack8(S.tq[2 * d0], S.tq[2 * d0 + 1]); }
    __syncthreads();
#undef RESC
#undef KBASE
#undef ACT
#undef MASKT
#undef SEAM_K0
#undef HALF_STEP
}
#undef ROW
#undef VMW
#undef VMWN
#undef SLOAD_H
#undef SWRITE_HK
#undef SWRITE_HV
#undef SWRITE_H
#undef SLOAD_F
#undef SWRITE_KF
#undef SWRITE_VF
}
namespace cg = cooperative_groups;
constexpr int NWAVES = 8;
constexpr int BATCH = 2, SEQ = 8192, DM = 2048, T = BATCH * SEQ, NIN = 6144, DFF = 5632, NGU = 2 * DFF, NMOD = 6 * DM;
constexpr float RMS_EPS = 1e-6f;
constexpr size_t MiB = 1u << 20;
constexpr size_t WS_MOD = 1 * MiB, WS_SSQ = 2 * MiB, WS_LSE = 4 * MiB, WS_CSA = 6 * MiB, WS_CSB = 14 * MiB;
constexpr size_t WS_WIN = 18 * MiB, WS_WOUT = 42 * MiB, WS_WGU = 50 * MiB, WS_WDN = 94 * MiB;
constexpr size_t WS_H = 116 * MiB, WS_OB0 = 116 * MiB, WS_OB1 = 148 * MiB, WS_H2 = 116 * MiB;
constexpr size_t WS_R = 180 * MiB;
constexpr size_t WS_QA = WS_R, WS_KA = WS_R + 32 * MiB, WS_VA = WS_R + 64 * MiB, WS_QB = WS_R + 96 * MiB, WS_KB = WS_R + 128 * MiB, WS_VB = WS_R + 160 * MiB;
constexpr size_t WS_OA = WS_R + 192 * MiB;
constexpr size_t WS_MIX = WS_R, WS_Y = WS_R + 64 * MiB, WS_ACT = WS_R, WS_F = WS_R + 176 * MiB, WS_END = WS_R + 304 * MiB;
constexpr int LDS_BYTES = 147456;

typedef unsigned short bf16;
typedef unsigned v4u __attribute__((ext_vector_type(4)));
typedef unsigned v2u __attribute__((ext_vector_type(2)));
typedef float f32x4 __attribute__((ext_vector_type(4)));
#define LAS __attribute__((address_space(3)))
#define LDS_WAIT() asm volatile("s_waitcnt lgkmcnt(0)" ::: "memory")
__device__ __forceinline__ unsigned f2bf(float f) { unsigned u = __builtin_bit_cast(unsigned, f); return (u + 0x7fffu + ((u >> 16) & 1u)) >> 16; }
__device__ __forceinline__ unsigned pk2(float lo, float hi) { return f2bf(lo) | (f2bf(hi) << 16); }
__device__ __forceinline__ float bflo(unsigned w) { return __builtin_bit_cast(float, w << 16); }
__device__ __forceinline__ float bfhi(unsigned w) { return __builtin_bit_cast(float, w & 0xffff0000u); }
__device__ __forceinline__ float wave_sum(float v) {
#pragma unroll
    for (int o = 1; o < 64; o <<= 1) v += __shfl_xor(v, o);
    return v;
}
__device__ __forceinline__ float sum16(float v) { v += __shfl_xor(v, 1); v += __shfl_xor(v, 2); v += __shfl_xor(v, 4); v += __shfl_xor(v, 8); return v; }

__device__ const double INV_FREQ[64] = {
  1.0, 0.8659643233600653, 0.7498942093324559, 0.6493816315762113,
  0.5623413251903491, 0.4869675251658631, 0.4216965034285822, 0.3651741272548377,
  0.31622776601683794, 0.27384196342643613, 0.23713737056616552, 0.2053525026457146,
  0.1778279410038923, 0.1539926526059492, 0.1333521432163324, 0.11547819846894582,
  0.1, 0.08659643233600653, 0.07498942093324558, 0.06493816315762113,
  0.05623413251903491, 0.04869675251658631, 0.042169650342858224, 0.03651741272548377,
  0.03162277660168379, 0.027384196342643614, 0.023713737056616554, 0.02053525026457146,
  0.01778279410038923, 0.01539926526059492, 0.01333521432163324, 0.011547819846894581,
  0.01, 0.008659643233600654, 0.007498942093324558, 0.006493816315762113,
  0.005623413251903491, 0.004869675251658631, 0.004216965034285823, 0.003651741272548377,
  0.0031622776601683794, 0.0027384196342643613, 0.0023713737056616554, 0.002053525026457146,
  0.0017782794100389228, 0.001539926526059492, 0.001333521432163324, 0.0011547819846894581,
  0.001, 0.0008659643233600654, 0.0007498942093324559, 0.0006493816315762113,
  0.0005623413251903491, 0.0004869675251658631, 0.00042169650342858224, 0.0003651741272548377,
  0.00031622776601683794, 0.0002738419634264361, 0.00023713737056616554, 0.0002053525026457146,
  0.00017782794100389227, 0.0001539926526059492, 0.0001333521432163324, 0.00011547819846894582,
};
__device__ __forceinline__ void sincos_d(double a, float& co, float& si) {
    const double k = __builtin_rint(a * 0.63661977236758134308);
    double r = __builtin_fma(-k, 1.57079632679489655800e+00, a); r = __builtin_fma(-k, 6.12323399573676603587e-17, r);
    const double r2 = r * r;
    double sp = 1.0 / 6227020800.0; sp = sp * r2 - 1.0 / 39916800.0; sp = sp * r2 + 1.0 / 362880.0; sp = sp * r2 - 1.0 / 5040.0; sp = sp * r2 + 1.0 / 120.0; sp = sp * r2 - 1.0 / 6.0;
    const double sn = r + r * r2 * sp;
    double cp = -1.0 / 87178291200.0; cp = cp * r2 + 1.0 / 479001600.0; cp = cp * r2 - 1.0 / 3628800.0; cp = cp * r2 + 1.0 / 40320.0; cp = cp * r2 - 1.0 / 720.0; cp = cp * r2 + 1.0 / 24.0; cp = cp * r2 - 0.5;
    const double cs = 1.0 + r2 * cp;
    const int q = ((int)k) & 3;
    const double c = (q == 0) ? cs : (q == 1) ? -sn : (q == 2) ? -cs : sn;
    const double s = (q == 0) ? sn : (q == 1) ? cs : (q == 2) ? -sn : -cs;
    co = (float)c; si = (float)s;
}

struct Args { const float* in[20]; float* out; unsigned char* ws; };
enum { I_X = 0, I_C, I_POS, I_WADA, I_BADA, I_GPREA, I_WIN, I_GOUTA, I_LQ1, I_LK1, I_LQ2, I_LK2, I_GSUB, I_WOUT, I_GPOSTA, I_GPREF, I_WGATE, I_WUP, I_WDOWN, I_GPOSTF };

__device__ __forceinline__ void transpose_item(const float* W, int K, int N, bf16* WT, int dst_row0, int k0, int n0, LAS float* scr, int lane) {
#pragma unroll
    for (int i = 0; i < 8; ++i) { const int kk = 8 * i + (lane >> 3), c4 = (lane & 7) * 4; const f32x4 v = *(const f32x4*)(W + (size_t)(k0 + kk) * N + n0 + c4);
        LAS float* d = scr + kk * 33 + c4; d[0] = v[0]; d[1] = v[1]; d[2] = v[2]; d[3] = v[3]; }
    LDS_WAIT(); asm volatile("" ::: "memory");
    const int c = lane & 7;
#pragma unroll
    for (int j = 0; j < 4; ++j) { const int n = (lane >> 3) + 8 * j; const LAS float* s = scr + (8 * c) * 33 + n;
        v4u o; o.x = pk2(s[0 * 33], s[1 * 33]); o.y = pk2(s[2 * 33], s[3 * 33]); o.z = pk2(s[4 * 33], s[5 * 33]); o.w = pk2(s[6 * 33], s[7 * 33]);
        *(v4u*)(WT + (size_t)(dst_row0 + n) * K + k0 + 8 * c) = o; }
    LDS_WAIT(); asm volatile("" ::: "memory");
}
__device__ __forceinline__ int win_dst_row(int n0) {
    const int pn = n0 >> 8, loc = n0 & 255, kind = pn >> 2; int nl = loc;
    if (kind == 0 || kind == 1) nl = 128 * ((loc >> 6) & 1) + 64 * (loc >> 7) + (loc & 63);
    else if (kind == 3 || kind == 4) nl = 128 * ((loc >> 5) & 1) + 32 * (loc >> 6) + (loc & 31);
    return pn * 256 + nl;
}

#define AIN(i) ((const float*)kargs_[(i)])
#define PHASE_PTRS() \
    typedef const void* __attribute__((address_space(4))) const kargp_t; kargp_t* kargs_ = (kargp_t*)__builtin_amdgcn_kernarg_segment_ptr(); asm volatile("" : "+s"(kargs_)); \
    unsigned char* ws = (unsigned char*)kargs_[21]; \
    int tid = threadIdx.x; asm volatile("" : "+v"(tid)); const int lane = tid & 63, wave = __builtin_amdgcn_readfirstlane(tid >> 6); \
    const int G = gridDim.x, bx = blockIdx.x; const int vcu = (bx % 8) * (G / 8) + bx / 8; \
    const int gw = bx * NWAVES + wave, NGW = G * NWAVES; (void)vcu; (void)gw; (void)NGW; (void)lane; \
    const float* x = AIN(I_X); \
    float* MOD = (float*)(ws + WS_MOD); float* SSQ = (float*)(ws + WS_SSQ); float* LSE = (float*)(ws + WS_LSE); \
    float* CSA = (float*)(ws + WS_CSA); float* CSB = (float*)(ws + WS_CSB); \
    bf16* WIN = (bf16*)(ws + WS_WIN); bf16* WOUT = (bf16*)(ws + WS_WOUT); bf16* WGU = (bf16*)(ws + WS_WGU); bf16* WDN = (bf16*)(ws + WS_WDN); \
    bf16* HB = (bf16*)(ws + WS_H); bf16* H2 = (bf16*)(ws + WS_H2); bf16* OB0 = (bf16*)(ws + WS_OB0); bf16* OB1 = (bf16*)(ws + WS_OB1); \
    bf16* QA = (bf16*)(ws + WS_QA); bf16* KA = (bf16*)(ws + WS_KA); bf16* VA = (bf16*)(ws + WS_VA); \
    bf16* QB = (bf16*)(ws + WS_QB); bf16* KB = (bf16*)(ws + WS_KB); bf16* VB = (bf16*)(ws + WS_VB); \
    bf16* OA = (bf16*)(ws + WS_OA); bf16* MIX = (bf16*)(ws + WS_MIX); float* Y = (float*)(ws + WS_Y); bf16* ACT = (bf16*)(ws + WS_ACT); float* F = (float*)(ws + WS_F); \
    (void)0
struct DiffUnit { int b, hq, hv, qb, m; };
struct DiffSched { int vcu;
  __device__ __forceinline__ bool next(int i, DiffUnit& u) const { if (i >= 8) return false; const int s = vcu & 15, bh = vcu >> 4; u.b = bh >> 3; const int h = bh & 7; u.m = (i >> 1) & 1; u.hq = u.m * 8 + h; u.hv = 2 * h + (i & 1); u.qb = (i & 4) ? 31 - s : s; return true; } };
#define RUNS(lo, hi, k) ((k) >= (lo) && (k) <= (hi))
#define RUN(k) (MODE == 0 || (MODE == 1 && RUNS(0, 2, k)) || (MODE == 2 && (k) == 3) || (MODE == 3 && (k) == 4) || (MODE == 4 && RUNS(5, 10, k)))
#define SYNC(k) (MODE == 0 || (MODE == 1 && (k) < 2) || (MODE == 4 && (k) >= 5))
template <int MODE> __global__ void __launch_bounds__(NWAVES * 64, 2) fwd_megakernel(Args args) {
    extern __shared__ __attribute__((aligned(16))) unsigned char lds[];
    if constexpr (RUN(0)) {
        PHASE_PTRS();
        const bool split = G >= 96; const int nada = 48;
        if (!split || bx < nada) {
            for (int chunk = bx; chunk < nada; chunk += (split ? nada : G)) {
                LAS float* sil = (LAS float*)lds; LAS float* red = (LAS float*)(lds + 16384);
                const float* cv = AIN(I_C);
                for (int i = tid; i < 2 * DM; i += NWAVES * 64) { const float c = cv[i]; sil[i] = c / (1.0f + __expf(-c)); }
                __syncthreads();
                const float* wa = AIN(I_WADA) + chunk * 256 + 4 * lane;
                f32x4 a0 = {0.f, 0.f, 0.f, 0.f}, a1 = {0.f, 0.f, 0.f, 0.f};
                const int kbeg = wave * 256;
#pragma unroll 1
                for (int k = kbeg; k < kbeg + 256; k += 8) {
                    f32x4 w[8];
#pragma unroll
                    for (int j = 0; j < 8; ++j) w[j] = *(const f32x4*)(wa + (size_t)(k + j) * NMOD);
#pragma unroll
                    for (int j = 0; j < 8; ++j) { const float s0 = sil[k + j], s1 = sil[DM + k + j]; a0 += w[j] * s0; a1 += w[j] * s1; }
                }
#pragma unroll
                for (int i = 0; i < 4; ++i) { red[(wave * 2 + 0) * 256 + 4 * lane + i] = a0[i]; red[(wave * 2 + 1) * 256 + 4 * lane + i] = a1[i]; }
                __syncthreads();
                { const int b = tid >> 8, c = tid & 255; float s = 0.f;
#pragma unroll
                  for (int w8 = 0; w8 < 8; ++w8) s += red[(w8 * 2 + b) * 256 + c];
                  MOD[b * NMOD + chunk * 256 + c] = s + AIN(I_BADA)[chunk * 256 + c]; }
                __syncthreads();
            }
        }
        if (!split || bx >= nada) {
            const int cb = split ? bx - nada : bx, CG = split ? G - nada : G;
            const int cw = cb * NWAVES + wave, NCW = CG * NWAVES;
            LAS float* scr = (LAS float*)(lds + 32768 + wave * 8704);
            constexpr int I_IN = (DM / 64) * (NIN / 32), I_OUT = (DM / 64) * (DM / 32), I_G = (DM / 64) * (DFF / 32), I_D = (DFF / 64) * (DM / 32);
            constexpr int NITEMS = I_IN + I_OUT + 2 * I_G + I_D;
#pragma unroll 1
            for (int it = cw; it < NITEMS; it += NCW) {
                int r = it;
                if (r < I_IN) { const int nb = NIN / 32, kb = r / nb, n0 = (r % nb) * 32; transpose_item(AIN(I_WIN), DM, NIN, WIN, win_dst_row(n0), kb * 64, n0, scr, lane); continue; } r -= I_IN;
                if (r < I_OUT) { const int nb = DM / 32, kb = r / nb, n0 = (r % nb) * 32; transpose_item(AIN(I_WOUT), DM, DM, WOUT, n0, kb * 64, n0, scr, lane); continue; } r -= I_OUT;
                if (r < I_G) { const int nb = DFF / 32, kb = r / nb, n0 = (r % nb) * 32; transpose_item(AIN(I_WGATE), DM, DFF, WGU, (n0 >> 7) * 256 + (n0 & 127), kb * 64, n0, scr, lane); continue; } r -= I_G;
                if (r < I_G) { const int nb = DFF / 32, kb = r / nb, n0 = (r % nb) * 32; transpose_item(AIN(I_WUP), DM, DFF, WGU, (n0 >> 7) * 256 + 128 + (n0 & 127), kb * 64, n0, scr, lane); continue; } r -= I_G;
                { const int nb = DM / 32, kb = r / nb, n0 = (r % nb) * 32; transpose_item(AIN(I_WDOWN), DFF, DM, WDN, n0, kb * 64, n0, scr, lane); }
            }
            const int* pos = (const int*)AIN(I_POS);
            const int ct = cb * (NWAVES * 64) + tid, NCT = CG * NWAVES * 64;
#pragma unroll 1
            for (int i = ct; i < T * 96; i += NCT) {
                if (i < T * 64) { const int t = i >> 6, e = i & 63; float co, si; sincos_d((double)pos[t] * INV_FREQ[e], co, si); *(float2*)(CSA + (size_t)i * 2) = make_float2(co, si); }
                else { const int i2 = i - T * 64, t = i2 >> 5, e = i2 & 31; float co, si; sincos_d((double)pos[t] * INV_FREQ[2 * e], co, si); *(float2*)(CSB + (size_t)i2 * 2) = make_float2(co, si); }
            }
        }
    }
    if constexpr (SYNC(0)) cg::this_grid().sync();

    if constexpr (RUN(1)) {
        PHASE_PTRS();
        const float* g = AIN(I_GPREA);
#pragma unroll 1
        for (int m = gw; m < T; m += NGW) {
            const int b = m >> 13; const float* xr = x + (size_t)m * DM + 4 * lane; const float* sh = MOD + b * NMOD + 4 * lane; const float* sc = sh + DM;
            f32x4 v[8]; float ss = 0.f;
#pragma unroll
            for (int j = 0; j < 8; ++j) { v[j] = *(const f32x4*)(xr + 256 * j); ss += (v[j][0] * v[j][0] + v[j][1] * v[j][1]) + (v[j][2] * v[j][2] + v[j][3] * v[j][3]); }
            const float rstd = 1.0f / sqrtf(wave_sum(ss) * (1.0f / DM) + RMS_EPS);
            bf16* hr = HB + (size_t)m * DM + 4 * lane;
#pragma unroll
            for (int j = 0; j < 8; ++j) { const f32x4 gg = *(const f32x4*)(g + 4 * lane + 256 * j), s1 = *(const f32x4*)(sc + 256 * j), s0 = *(const f32x4*)(sh + 256 * j);
                const f32x4 o = (v[j] * rstd) * gg * (s1 + 1.0f) + s0; v2u w; w.x = pk2(o[0], o[1]); w.y = pk2(o[2], o[3]); *(v2u*)(hr + 256 * j) = w; }
        }
    }
    if constexpr (SYNC(1)) cg::this_grid().sync();

    if constexpr (RUN(2)) {
        PHASE_PTRS();
        pg8::Gemm gm{HB, WIN, T, NIN, DM}; pg8::StaticOrder S; S.init(T, NIN, G, bx);
        pg8::EpiInProj E{ws, attn_body::C2};
        static_assert(WS_CSA == pg8::EpiInProj::O_CSA && WS_CSB == pg8::EpiInProj::O_CSB && WS_QA == pg8::EpiInProj::O_QA && WS_KA == pg8::EpiInProj::O_KA && WS_VA == pg8::EpiInProj::O_VA && WS_QB == pg8::EpiInProj::O_QB && WS_KB == pg8::EpiInProj::O_KB && WS_VB == pg8::EpiInProj::O_VB, "workspace map");
        pg8::gemm_phase<pg8::EpiInProj, pg8::StaticOrder, true, true>((PG8_LAS unsigned char*)lds, gm, S, E);
    }
    if constexpr (SYNC(2)) cg::this_grid().sync();

    if constexpr (RUN(3) || RUN(4)) {
        PHASE_PTRS();
        using BR = swa::BlockRef<swa::bf16, swa::bf16>;
        constexpr int NIT = 16 * 96;
        auto mk = [](int id, bf16* QA_, bf16* KA_, bf16* VA_, bf16* OA_, float* LSE_) -> BR {
            const int bh = id / 96, rem = id % 96, p = rem >> 5, blk = rem & 31, sh2 = 2 * p, d = 1 << sh2, nblk = 32 >> sh2, r = blk / nblk, qb = blk % nblk;
            BR br; const size_t base = ((size_t)bh * SEQ + r) * 128, qoff = (size_t)qb * 256 * d * 128;
            br.Q = (const swa::bf16*)(QA_ + base + qoff); br.K = (const swa::bf16*)(KA_ + base); br.V = (const swa::bf16*)(VA_ + base);
            br.O = (swa::bf16*)(OA_ + (size_t)p * ((size_t)T * 1024) + base + qoff);
            br.LSE = LSE_ + (size_t)p * (16 * SEQ) + (size_t)bh * SEQ + r + (size_t)qb * 256 * d;
            br.P0 = qb * 256; br.rs = 128 * d; br.ls = d; return br;
        };
        if constexpr (RUN(3)) {
        int id = bx;
        if (id < NIT) {
            BR cur = mk(id, QA, KA, VA, OA, LSE);
            swa::Seam<swa::bf16> Sm;
            swa::causal_swa_prime<swa::bf16, swa::bf16>(cur, 129, (char*)lds, Sm);
#pragma unroll 1
            for (;;) {
                const bool last = id + G >= NIT;
                const BR nxt = last ? cur : mk(id + G, QA, KA, VA, OA, LSE);
                swa::causal_swa_block<swa::bf16, swa::bf16>(cur, nxt, SEQ, 129, (char*)lds, Sm);
                if (last) break;
                cur = nxt; id += G;
            }
        }
        }
        __syncthreads();
        if constexpr (RUN(4))
        { DiffSched S; S.vcu = vcu; DiffUnit u;
          for (int i = 0; S.next(i, u); ++i) attn_body::attn_unit<8>(u.b, u.hq, u.hv, u.qb, (const attn_body::bf16*)QB, (const attn_body::bf16*)KB, (const attn_body::bf16*)VB, (attn_body::bf16*)(u.m ? OB1 : OB0), (char*)lds); }
    }
    if constexpr (SYNC(4)) cg::this_grid().sync();

    if constexpr (RUN(5)) {
        PHASE_PTRS();
        const float lam = __expf(wave_sum(AIN(I_LQ1)[lane] * AIN(I_LK1)[lane])) - __expf(wave_sum(AIN(I_LQ2)[lane] * AIN(I_LK2)[lane])) + 0.2f;
        const int hl = lane >> 4, c = lane & 15;
        f32x4 ga0 = *(const f32x4*)(AIN(I_GOUTA) + c * 8), ga1 = *(const f32x4*)(AIN(I_GOUTA) + c * 8 + 4);
        f32x4 gb0 = *(const f32x4*)(AIN(I_GSUB) + c * 8) * 0.8f, gb1 = *(const f32x4*)(AIN(I_GSUB) + c * 8 + 4) * 0.8f;
#pragma unroll 1
        for (int t = gw; t < T; t += NGW) {
            const int b = t >> 13, s = t & 8191;
#pragma unroll
            for (int st = 0; st < 2; ++st) {
                const int head = 4 * st + hl; const size_t ro = (size_t)(b * 8 + head) * SEQ + s;
                const float l0 = LSE[ro], l1 = LSE[16 * SEQ + ro], l2 = LSE[32 * SEQ + ro];
                const float mx = fmaxf(l0, fmaxf(l1, l2)); float w0 = __expf(l0 - mx), w1 = __expf(l1 - mx), w2 = __expf(l2 - mx); const float inv = 1.0f / (w0 + w1 + w2); w0 *= inv; w1 *= inv; w2 *= inv;
                const v4u a = *(const v4u*)(OA + ro * 128 + c * 8), bq = *(const v4u*)(OA + (size_t)T * 1024 + ro * 128 + c * 8), cq = *(const v4u*)(OA + 2 * (size_t)T * 1024 + ro * 128 + c * 8);
                float o[8];
#pragma unroll
                for (int i = 0; i < 4; ++i) { o[2 * i] = w0 * bflo(a[i]) + w1 * bflo(bq[i]) + w2 * bflo(cq[i]); o[2 * i + 1] = w0 * bfhi(a[i]) + w1 * bfhi(bq[i]) + w2 * bfhi(cq[i]); }
                float ss = 0.f;
#pragma unroll
                for (int i = 0; i < 8; ++i) ss += o[i] * o[i];
                const float rstd = 1.0f / sqrtf(sum16(ss) * (1.0f / 128.0f) + RMS_EPS);
                v4u w; w.x = pk2(o[0] * rstd * ga0[0], o[1] * rstd * ga0[1]); w.y = pk2(o[2] * rstd * ga0[2], o[3] * rstd * ga0[3]); w.z = pk2(o[4] * rstd * ga1[0], o[5] * rstd * ga1[1]); w.w = pk2(o[6] * rstd * ga1[2], o[7] * rstd * ga1[3]);
                *(v4u*)(MIX + (size_t)t * DM + head * 128 + c * 8) = w;
            }
#pragma unroll
            for (int st = 0; st < 2; ++st) {
                const int head = 4 * st + hl; const size_t off = (size_t)t * 1024 + head * 128 + c * 8;
                const v4u a = *(const v4u*)(OB0 + off), bq = *(const v4u*)(OB1 + off);
                float o[8];
#pragma unroll
                for (int i = 0; i < 4; ++i) { o[2 * i] = bflo(a[i]) - lam * bflo(bq[i]); o[2 * i + 1] = bfhi(a[i]) - lam * bfhi(bq[i]); }
                float ss = 0.f;
#pragma unroll
                for (int i = 0; i < 8; ++i) ss += o[i] * o[i];
                const float rstd = 1.0f / sqrtf(sum16(ss) * (1.0f / 128.0f) + RMS_EPS);
                v4u w; w.x = pk2(o[0] * rstd * gb0[0], o[1] * rstd * gb0[1]); w.y = pk2(o[2] * rstd * gb0[2], o[3] * rstd * gb0[3]); w.z = pk2(o[4] * rstd * gb1[0], o[5] * rstd * gb1[1]); w.w = pk2(o[6] * rstd * gb1[2], o[7] * rstd * gb1[3]);
                *(v4u*)(MIX + (size_t)t * DM + 1024 + head * 128 + c * 8) = w;
            }
        }
    }
    if constexpr (SYNC(5)) cg::this_grid().sync();

    if constexpr (RUN(6)) {
        PHASE_PTRS();
        pg8::Gemm gm{MIX, WOUT, T, DM, DM}; pg8::StaticOrder S; S.init(T, DM, G, bx);
        pg8::EpiF32Ssq E{Y, DM, SSQ};
        pg8::gemm_phase<pg8::EpiF32Ssq, pg8::StaticOrder, true, true>((PG8_LAS unsigned char*)lds, gm, S, E);
    }
    if constexpr (SYNC(6)) cg::this_grid().sync();

    if constexpr (RUN(7)) {
        PHASE_PTRS();
        const float* gpa = AIN(I_GPOSTA); const float* gpf = AIN(I_GPREF);
#pragma unroll 1
        for (int m = gw; m < T; m += NGW) {
            const int b = m >> 13; const float* mod = MOD + b * NMOD + 4 * lane;
            const float sq = wave_sum(lane < 32 ? SSQ[(size_t)m * 32 + lane] : 0.f);
            const float rstdy = 1.0f / sqrtf(sq * (1.0f / DM) + RMS_EPS);
            const float* yr = Y + (size_t)m * DM + 4 * lane; const float* xr = x + (size_t)m * DM + 4 * lane; float* x1r = ((float*)kargs_[20]) + (size_t)m * DM + 4 * lane;
            f32x4 v[8]; float ss = 0.f;
#pragma unroll
            for (int j = 0; j < 8; ++j) { const f32x4 yy = *(const f32x4*)(yr + 256 * j), xx = *(const f32x4*)(xr + 256 * j), gt = *(const f32x4*)(mod + 2 * DM + 256 * j), gp = *(const f32x4*)(gpa + 4 * lane + 256 * j);
                v[j] = xx + gt * ((yy * rstdy) * gp); *(f32x4*)(x1r + 256 * j) = v[j]; ss += (v[j][0] * v[j][0] + v[j][1] * v[j][1]) + (v[j][2] * v[j][2] + v[j][3] * v[j][3]); }
            const float rstd = 1.0f / sqrtf(wave_sum(ss) * (1.0f / DM) + RMS_EPS);
            bf16* hr = H2 + (size_t)m * DM + 4 * lane;
#pragma unroll
            for (int j = 0; j < 8; ++j) { const f32x4 gg = *(const f32x4*)(gpf + 4 * lane + 256 * j), s0 = *(const f32x4*)(mod + 3 * DM + 256 * j), s1 = *(const f32x4*)(mod + 4 * DM + 256 * j);
                const f32x4 o = (v[j] * rstd) * gg * (s1 + 1.0f) + s0; v2u w; w.x = pk2(o[0], o[1]); w.y = pk2(o[2], o[3]); *(v2u*)(hr + 256 * j) = w; }
        }
    }
    if constexpr (SYNC(7)) cg::this_grid().sync();

    if constexpr (RUN(8)) {
        PHASE_PTRS();
        pg8::Gemm gm{H2, WGU, T, NGU, DM}; pg8::StaticOrder S; S.init(T, NGU, G, bx);
        pg8::EpiSwiGLU E{ACT, DFF};
        pg8::gemm_phase<pg8::EpiSwiGLU, pg8::StaticOrder, true, true>((PG8_LAS unsigned char*)lds, gm, S, E);
    }
    if constexpr (SYNC(8)) cg::this_grid().sync();

    if constexpr (RUN(9)) {
        PHASE_PTRS();
        pg8::Gemm gm{ACT, WDN, T, DM, DFF}; pg8::StaticOrder S; S.init(T, DM, G, bx);
        pg8::EpiF32Ssq E{F, DM, SSQ};
        pg8::gemm_phase<pg8::EpiF32Ssq, pg8::StaticOrder, true, true>((PG8_LAS unsigned char*)lds, gm, S, E);
    }
    if constexpr (SYNC(9)) cg::this_grid().sync();

    if constexpr (RUN(10)) {
        PHASE_PTRS();
        const float* gpf = AIN(I_GPOSTF);
#pragma unroll 1
        for (int m = gw; m < T; m += NGW) {
            const int b = m >> 13; const float* mod = MOD + b * NMOD + 5 * DM + 4 * lane;
            const float sq = wave_sum(lane < 32 ? SSQ[(size_t)m * 32 + lane] : 0.f);
            const float rstdf = 1.0f / sqrtf(sq * (1.0f / DM) + RMS_EPS);
            const float* fr = F + (size_t)m * DM + 4 * lane; float* orow = ((float*)kargs_[20]) + (size_t)m * DM + 4 * lane;
#pragma unroll
            for (int j = 0; j < 8; ++j) { const f32x4 ff = *(const f32x4*)(fr + 256 * j), xx = *(const f32x4*)(orow + 256 * j), gt = *(const f32x4*)(mod + 256 * j), gp = *(const f32x4*)(gpf + 4 * lane + 256 * j);
                *(f32x4*)(orow + 256 * j) = xx + gt * ((ff * rstdf) * gp); }
        }
    }
}

extern "C" void kernel_launch(void* const* d_in, const int* in_sizes, int n_in, void* d_out, int out_size, void* d_ws, size_t ws_size, hipStream_t stream) {
    static int grid = 0;
    if (grid == 0) {
        if (n_in != 20 || in_sizes[0] != T * DM || out_size != T * DM || ws_size < WS_END) { fprintf(stderr, "kernel_launch: unexpected shapes / workspace (n_in %d, ws %zu, need %zu)\n", n_in, ws_size, (size_t)WS_END); grid = -1; return; }
        int dev = 0, cus = 0, per_cu = 0;
        if (hipGetDevice(&dev) != hipSuccess || hipDeviceGetAttribute(&cus, hipDeviceAttributeMultiprocessorCount, dev) != hipSuccess) { grid = -1; return; }
#if defined(MK_ONE_LAUNCH)
        const void* fns[1] = {(const void*)fwd_megakernel<0>};
#else
        const void* fns[4] = {(const void*)fwd_megakernel<1>, (const void*)fwd_megakernel<2>, (const void*)fwd_megakernel<3>, (const void*)fwd_megakernel<4>};
#endif
        for (const void* fn : fns) if (hipFuncSetAttribute(fn, hipFuncAttributeMaxDynamicSharedMemorySize, LDS_BYTES) != hipSuccess) { fprintf(stderr, "kernel_launch: hipFuncSetAttribute failed\n"); grid = -1; return; }
        if (hipOccupancyMaxActiveBlocksPerMultiprocessor(&per_cu, fns[0], NWAVES * 64, LDS_BYTES) != hipSuccess || per_cu < 1) { fprintf(stderr, "kernel_launch: occupancy query says %d blocks per CU\n", per_cu); (void)hipGetLastError(); grid = -1; return; }
        grid = cus * per_cu;
    }
    if (grid < 0) return;
    Args a{};
    for (int i = 0; i < 20; ++i) a.in[i] = (const float*)d_in[i];
    a.out = (float*)d_out; a.ws = (unsigned char*)d_ws;
    void* kargs[] = {&a};
#if defined(MK_ONE_LAUNCH)
    hipError_t e = hipLaunchCooperativeKernel((const void*)fwd_megakernel<0>, dim3(grid), dim3(NWAVES * 64), kargs, LDS_BYTES, stream);
    if (e != hipSuccess) fprintf(stderr, "kernel_launch: cooperative launch failed: %s (grid %d)\n", hipGetErrorString(e), grid);
#else
    hipError_t e = hipLaunchCooperativeKernel((const void*)fwd_megakernel<1>, dim3(grid), dim3(NWAVES * 64), kargs, LDS_BYTES, stream);
    if (e != hipSuccess) fprintf(stderr, "kernel_launch: cooperative launch 1 failed: %s (grid %d)\n", hipGetErrorString(e), grid);
    hipLaunchKernelGGL(fwd_megakernel<2>, dim3(grid), dim3(NWAVES * 64), LDS_BYTES, stream, a);
    hipLaunchKernelGGL(fwd_megakernel<3>, dim3(grid), dim3(NWAVES * 64), LDS_BYTES, stream, a);
    e = hipLaunchCooperativeKernel((const void*)fwd_megakernel<4>, dim3(grid), dim3(NWAVES * 64), kargs, LDS_BYTES, stream);
    if (e != hipSuccess) fprintf(stderr, "kernel_launch: cooperative launch 4 failed: %s (grid %d)\n", hipGetErrorString(e), grid);
#endif
}
```

```cpp
#ifndef MK_MULTI_LAUNCH
#define MK_ONE_LAUNCH 1
#endif
#include <hip/hip_runtime.h>
#include <hip/hip_bf16.h>
#include <hip/hip_cooperative_groups.h>
#include <cstdio>
#include <cstdint>
#include <cmath>
namespace pg8 {
#define PG8_LAS __attribute__((address_space(3)))
typedef unsigned short bf16_t;
typedef short bf16x8 __attribute__((ext_vector_type(8)));
typedef float f32x4 __attribute__((ext_vector_type(4)));
typedef unsigned u32x4 __attribute__((ext_vector_type(4)));
constexpr int BM = 256, BK = 64, HALF = 128, HTB = HALF * BK * 2  , STAGE_BYTES = 8 * HTB, NXCD = 8, WGM = 8;

__host__ __device__ __forceinline__ int lds_byte(int r, int c) { const int st = (r >> 4) * 2 + (c >> 5), rr = r & 15, cc = c & 31, ob = rr * 64 + cc * 2; return st * 1024 + (ob ^ (((ob >> 9) & 1) << 5)); }
__host__ __device__ __forceinline__ void stage_rc(int b, int& R, int& C) { const int st = b / 1024, sb = b % 1024, swz = sb ^ (((sb >> 9) & 1) << 5); R = (st >> 1) * 16 + swz / 64; C = (st & 1) * 32 + (swz % 64) / 2; }
__host__ __device__ __forceinline__ int perm32(int rho) { const int n = rho >> 4, i = rho & 15; return 8 * (i >> 2) + 4 * n + (i & 3); }

struct Unit { int pm, pn; };
struct Gemm { const bf16_t* A; const bf16_t* Bt; int M, N, K; };

struct StaticOrder {
    int nM, nN, nwg, G, c;
    __host__ __device__ void init(int M, int N, int G_, int c_) { nM = M / BM; nN = N / BM; nwg = nM * nN; G = G_; c = c_; }
    __host__ __device__ bool next(int i, Unit& u) const {
        const long L = (long)i * G + c; if (L >= nwg) return false;
        int wgid = (int)L; { const int q = nwg / NXCD, r = nwg % NXCD, xcd = wgid % NXCD, off = wgid / NXCD; wgid = (xcd < r ? xcd * (q + 1) : r * (q + 1) + (xcd - r) * q) + off; }
        const int nig = WGM * nN, gid = wgid / nig, fm = gid * WGM, gsz = (nM - fm) < WGM ? (nM - fm) : WGM;
        u.pm = fm + ((wgid % nig) % gsz); u.pn = (wgid % nig) / gsz; return true;
    }
    __device__ __forceinline__ void a_ready(const Unit&) const {}
    __device__ __forceinline__ void done(const Unit&) const {}
};

__device__ __forceinline__ unsigned cvt_pk_bf16(float lo, float hi) { unsigned r; asm volatile("v_cvt_pk_bf16_f32 %0, %1, %2" : "=v"(r) : "v"(lo), "v"(hi)); return r; }
typedef float f32x2 __attribute__((ext_vector_type(2)));
__device__ __forceinline__ f32x2 gelu_pk(f32x2 v) {
    const f32x2 av = __builtin_elementwise_abs(v), d = av * 0.2316418882f + 1.0f;
    f32x2 t; t.x = __builtin_amdgcn_rcpf(d.x); t.y = __builtin_amdgcn_rcpf(d.y);
    f32x2 q = t * 0.5307027145f + (-0.7265760135f); q = q * t + 0.7107068705f; q = q * t + (-0.142248368f); q = q * t + 0.127414796f; q = q * t;
    const f32x2 s = (v * v) * (-0.72134752044f);
    f32x2 e; e.x = __builtin_amdgcn_exp2f(s.x); e.y = __builtin_amdgcn_exp2f(s.y);
    const f32x2 m = v * (q * e), r = v - m;
    f32x2 o; o.x = v.x < 0.f ? m.x : r.x; o.y = v.y < 0.f ? m.y : r.y; return o;
}

template <int ACT  > struct EpiBf16 {
    static constexpr bool PERM = true, AFTER_DRAIN = false; static_assert(ACT == 0 || ACT == 1, "EpiBf16: ACT is 0 (none) or 1 (gelu_pk)");
    bf16_t* O; int ldc; const float* bias; int split_cols; size_t split_stride; float scale0;
    __device__ __forceinline__ void operator()(const f32x4 (&acc)[2][2][4][2], const Unit& u, int wr, int wc, int fr, int fq) const {
        const int row0 = u.pm * BM + wr * 64 + fr; int colt = u.pn * BM; bf16_t* base = O;
        float sc = 1.f; if (split_cols) { const int t = colt / split_cols; base += (size_t)t * split_stride; colt -= t * split_cols; if (t == 0) sc = scale0; }
        const int col0 = colt + wc * 32 + 8 * fq, bcol0 = u.pn * BM + wc * 32 + 8 * fq;
        f32x4 bv[2][2];
#pragma unroll
        for (int bj = 0; bj < 2; ++bj)
#pragma unroll
            for (int n = 0; n < 2; ++n) bv[bj][n] = bias ? *(const f32x4*)(bias + bcol0 + bj * HALF + 4 * n) : (f32x4){0.f, 0.f, 0.f, 0.f};
#pragma unroll
        for (int ai = 0; ai < 2; ++ai)
#pragma unroll
            for (int m = 0; m < 4; ++m) { bf16_t* rowp = base + (size_t)(row0 + ai * HALF + m * 16) * ldc + col0;
#pragma unroll
                for (int bj = 0; bj < 2; ++bj) { f32x4 v0 = acc[ai][bj][m][0] + bv[bj][0], v1 = acc[ai][bj][m][1] + bv[bj][1];
                    if (ACT == 1) { f32x2 a = gelu_pk((f32x2){v0[0], v0[1]}), b = gelu_pk((f32x2){v0[2], v0[3]}), c = gelu_pk((f32x2){v1[0], v1[1]}), d = gelu_pk((f32x2){v1[2], v1[3]});
                        v0 = (f32x4){a.x, a.y, b.x, b.y}; v1 = (f32x4){c.x, c.y, d.x, d.y}; }
                    v0 = v0 * sc; v1 = v1 * sc; u32x4 w; w.x = cvt_pk_bf16(v0[0], v0[1]); w.y = cvt_pk_bf16(v0[2], v0[3]); w.z = cvt_pk_bf16(v1[0], v1[1]); w.w = cvt_pk_bf16(v1[2], v1[3]);
                    *(u32x4*)(rowp + bj * HALF) = w; } }
    }
};
__device__ __forceinline__ u32x4 pack8bf(const f32x4 a, const f32x4 b) { u32x4 w; w.x = cvt_pk_bf16(a[0], a[1]); w.y = cvt_pk_bf16(a[2], a[3]); w.z = cvt_pk_bf16(b[0], b[1]); w.w = cvt_pk_bf16(b[2], b[3]); return w; }
struct EpiInProj {
    static constexpr bool PERM = true, AFTER_DRAIN = false;
    unsigned char* ws; float qscale;
    static constexpr size_t M_ = 1u << 20, O_CSA = 6 * M_, O_CSB = 14 * M_, O_QA = 180 * M_, O_KA = 212 * M_, O_VA = 244 * M_, O_QB = 276 * M_, O_KB = 308 * M_, O_VB = 340 * M_;
    __device__ __forceinline__ void operator()(const f32x4 (&acc)[2][2][4][2], const Unit& u, int wr, int wc, int fr, int fq) const {
        const int kind = u.pn >> 2, tq = u.pn & 3, j0 = wc * 32 + 8 * fq, row0 = u.pm * BM + wr * 64 + fr;
        if (kind == 0 || kind == 1) {
            bf16_t* base = (bf16_t*)(ws + (kind == 0 ? O_QA : O_KA)); const float* csA = (const float*)(ws + O_CSA); const int hl = j0 >> 6, e0 = j0 & 63, head = 2 * tq + hl;
#pragma unroll
            for (int ai = 0; ai < 2; ++ai)
#pragma unroll
                for (int m = 0; m < 4; ++m) { const int t = row0 + ai * HALF + m * 16, b = t >> 13, s = t & 8191;
                    const f32x4* cs = (const f32x4*)(csA + ((size_t)t * 64 + e0) * 2); const f32x4 c0 = cs[0], c1 = cs[1], c2 = cs[2], c3 = cs[3];
                    const f32x4 coa = {c0[0], c0[2], c1[0], c1[2]}, sia = {c0[1], c0[3], c1[1], c1[3]}, cob = {c2[0], c2[2], c3[0], c3[2]}, sib = {c2[1], c2[3], c3[1], c3[3]};
                    const f32x4 x1a = acc[ai][0][m][0], x1b = acc[ai][0][m][1], x2a = acc[ai][1][m][0], x2b = acc[ai][1][m][1];
                    const f32x4 y1a = x1a * coa - x2a * sia, y1b = x1b * cob - x2b * sib, y2a = x2a * coa + x1a * sia, y2b = x2b * cob + x1b * sib;
                    bf16_t* dst = base + ((size_t)(b * 8 + head) * 8192 + s) * 128 + e0;
                    *(u32x4*)dst = pack8bf(y1a, y1b); *(u32x4*)(dst + 64) = pack8bf(y2a, y2b); }
        } else if (kind == 2) {
#pragma unroll
            for (int ai = 0; ai < 2; ++ai)
#pragma unroll
                for (int m = 0; m < 4; ++m) { const int t = row0 + ai * HALF + m * 16, b = t >> 13, s = t & 8191;
#pragma unroll
                    for (int bj = 0; bj < 2; ++bj) { bf16_t* dst = (bf16_t*)(ws + O_VA) + ((size_t)(b * 8 + 2 * tq + bj) * 8192 + s) * 128 + j0; *(u32x4*)dst = pack8bf(acc[ai][bj][m][0], acc[ai][bj][m][1]); } }
        } else if (kind == 3 || kind == 4) {
            bf16_t* base = (bf16_t*)(ws + (kind == 3 ? O_QB : O_KB)); const float* csB = (const float*)(ws + O_CSB); const float sc = kind == 3 ? qscale : 1.0f; const int hl = j0 >> 5, e0 = j0 & 31, col = 256 * tq + hl * 64 + e0;
#pragma unroll
            for (int ai = 0; ai < 2; ++ai)
#pragma unroll
                for (int m = 0; m < 4; ++m) { const int t = row0 + ai * HALF + m * 16;
                    const f32x4* cs = (const f32x4*)(csB + ((size_t)t * 32 + e0) * 2); const f32x4 c0 = cs[0], c1 = cs[1], c2 = cs[2], c3 = cs[3];
                    const f32x4 coa = {c0[0], c0[2], c1[0], c1[2]}, sia = {c0[1], c0[3], c1[1], c1[3]}, cob = {c2[0], c2[2], c3[0], c3[2]}, sib = {c2[1], c2[3], c3[1], c3[3]};
                    const f32x4 x1a = acc[ai][0][m][0], x1b = acc[ai][0][m][1], x2a = acc[ai][1][m][0], x2b = acc[ai][1][m][1];
                    const f32x4 y1a = (x1a * coa - x2a * sia) * sc, y1b = (x1b * cob - x2b * sib) * sc, y2a = (x2a * coa + x1a * sia) * sc, y2b = (x2b * cob + x1b * sib) * sc;
                    bf16_t* dst = base + (size_t)t * 1024 + col;
                    *(u32x4*)dst = pack8bf(y1a, y1b); *(u32x4*)(dst + 32) = pack8bf(y2a, y2b); }
        } else {
#pragma unroll
            for (int ai = 0; ai < 2; ++ai)
#pragma unroll
                for (int m = 0; m < 4; ++m) { const int t = row0 + ai * HALF + m * 16;
#pragma unroll
                    for (int bj = 0; bj < 2; ++bj) { bf16_t* dst = (bf16_t*)(ws + O_VB) + (size_t)t * 1024 + 256 * tq + 128 * bj + j0; *(u32x4*)dst = pack8bf(acc[ai][bj][m][0], acc[ai][bj][m][1]); } }
        }
    }
};
struct EpiF32Ssq {
    static constexpr bool PERM = false, AFTER_DRAIN = false;
    float* Y; int ldc; float* ssq;
    __device__ __forceinline__ void operator()(const f32x4 (&acc)[2][2][4][2], const Unit& u, int wr, int wc, int fr, int fq) const {
        const int col0 = u.pn * BM + wc * 32 + 4 * fq;
#pragma unroll
        for (int ai = 0; ai < 2; ++ai)
#pragma unroll
            for (int m = 0; m < 4; ++m) { const int row = u.pm * BM + ai * HALF + wr * 64 + m * 16 + fr; float s = 0.f; float* yr = Y + (size_t)row * ldc + col0;
#pragma unroll
                for (int bj = 0; bj < 2; ++bj)
#pragma unroll
                    for (int n = 0; n < 2; ++n) { const f32x4 v = acc[ai][bj][m][n]; *(f32x4*)(yr + bj * HALF + n * 16) = v; s += (v[0] * v[0] + v[1] * v[1]) + (v[2] * v[2] + v[3] * v[3]); }
                s += __shfl_xor(s, 16); s += __shfl_xor(s, 32);
                if (fq == 0) ssq[(size_t)row * 32 + u.pn * 4 + wc] = s; }
    }
};
struct EpiSwiGLU {
    static constexpr bool PERM = true, AFTER_DRAIN = false;
    bf16_t* O; int ldc;
    __device__ __forceinline__ void operator()(const f32x4 (&acc)[2][2][4][2], const Unit& u, int wr, int wc, int fr, int fq) const {
        const int col0 = u.pn * HALF + wc * 32 + 8 * fq, row0 = u.pm * BM + wr * 64 + fr;
#pragma unroll
        for (int ai = 0; ai < 2; ++ai)
#pragma unroll
            for (int m = 0; m < 4; ++m) { f32x4 r[2];
#pragma unroll
                for (int n = 0; n < 2; ++n) { const f32x4 g = acc[ai][0][m][n], up = acc[ai][1][m][n];
#pragma unroll
                    for (int i = 0; i < 4; ++i) { const float e = __builtin_amdgcn_exp2f(-1.4426950408889634f * g[i]); r[n][i] = g[i] * __builtin_amdgcn_rcpf(1.0f + e) * up[i]; } }
                *(u32x4*)(O + (size_t)(row0 + ai * HALF + m * 16) * ldc + col0) = pack8bf(r[0], r[1]); }
    }
};
template <class Epi, class Sched, bool ALIGN_EPI = false, bool SP2 = false>
__device__ __forceinline__ void gemm_phase(PG8_LAS unsigned char* lds, const Gemm g, const Sched& S, const Epi& E, const int tid_in) {
    const int tid = tid_in, wid = __builtin_amdgcn_readfirstlane(tid >> 6), lane = tid & 63, wr = wid >> 2, wc = wid & 3, fr = lane & 15, fq = lane >> 4;
    const int K = g.K, nt = K / BK;
    unsigned voffA[2], voffB[2];
#pragma unroll
    for (int i = 0; i < 2; ++i) { int R, C; stage_rc(tid * 16 + i * 8192, R, C); const int Rb = Epi::PERM ? ((R & ~31) + perm32(R & 31)) : R;
        voffA[i] = (unsigned)(R * K + C) * 2u; voffB[i] = (unsigned)(Rb * K + C) * 2u; }
    const size_t kstep = (size_t)(BK * 2);
    const size_t hstep = (size_t)HALF * K * 2;
    const size_t tstep = 2 * hstep;
    const unsigned ldsw = (unsigned)wid * 1024u;
    const int aoff = lds_byte(wr * 64 + fr, fq * 8), boff = lds_byte(wc * 32 + fr, fq * 8);
#define PG8_SA(b, h) (((b) * 2 + (h)) * HTB)
#define PG8_SB(b, h) ((4 + (b) * 2 + (h)) * HTB)
#define PG8_STAGE(bufoff, gbase, voff) do { _Pragma("unroll") for (int _i = 0; _i < 2; ++_i) \
        __builtin_amdgcn_global_load_lds((const unsigned*)((const char*)(gbase) + (voff)[_i]), (PG8_LAS unsigned*)(lds + (bufoff) + ldsw + _i * 8192), 16, 0, 0); } while (0)
#define PG8_LDA(dst, b, h) do { _Pragma("unroll") for (int m = 0; m < 4; ++m) _Pragma("unroll") for (int k = 0; k < 2; ++k) dst[m][k] = *(const PG8_LAS bf16x8*)(lds + PG8_SA(b, h) + aoff + m * 2048 + k * 1024); } while (0)
#define PG8_LDB(dst, b, h) do { _Pragma("unroll") for (int n = 0; n < 2; ++n) _Pragma("unroll") for (int k = 0; k < 2; ++k) dst[n][k] = *(const PG8_LAS bf16x8*)(lds + PG8_SB(b, h) + boff + n * 2048 + k * 1024); } while (0)
#define PG8_MMA(ai, bj, At, Bt) do { __builtin_amdgcn_s_setprio(1); _Pragma("unroll") for (int m = 0; m < 4; ++m) _Pragma("unroll") for (int n = 0; n < 2; ++n) _Pragma("unroll") for (int k = 0; k < 2; ++k) \
        acc[ai][bj][m][n] = __builtin_amdgcn_mfma_f32_16x16x32_bf16(Bt[n][k], At[m][k], acc[ai][bj][m][n], 0, 0, 0); __builtin_amdgcn_s_setprio(0); } while (0)
#define PG8_WAIT_V(n) asm volatile("s_waitcnt vmcnt(" #n ")" ::: "memory")
#define PG8_WAIT_L(n) asm volatile("s_waitcnt lgkmcnt(" #n ")" ::: "memory")
#define PG8_BAR __builtin_amdgcn_s_barrier()
#define PG8_SCHED __builtin_amdgcn_sched_barrier(0)
    Unit cur, nxt; int ui = 0;
    if (!S.next(0, cur)) return;
    f32x4 acc[2][2][4][2];
#pragma unroll
    for (int a = 0; a < 2; ++a)
#pragma unroll
        for (int b = 0; b < 2; ++b)
#pragma unroll
            for (int m = 0; m < 4; ++m)
#pragma unroll
                for (int n = 0; n < 2; ++n) acc[a][b][m][n] = (f32x4){0.f, 0.f, 0.f, 0.f};
    bf16x8 At[4][2], B0[2][2], B1[2][2];
    const char* cA = (const char*)g.A + (size_t)cur.pm * tstep; const char* cB = (const char*)g.Bt + (size_t)cur.pn * tstep;
    S.a_ready(cur);
    if constexpr (SP2) {
        PG8_STAGE(PG8_SB(0, 0), cB, voffB); PG8_STAGE(PG8_SB(0, 1), cB + hstep, voffB); PG8_STAGE(PG8_SA(0, 0), cA, voffA); PG8_STAGE(PG8_SA(0, 1), cA + hstep, voffA);
        if (wr == 1) PG8_BAR;
        PG8_WAIT_V(2); PG8_BAR;
        PG8_STAGE(PG8_SB(1, 0), cB + kstep, voffB); PG8_STAGE(PG8_SA(1, 0), cA + kstep, voffA); PG8_STAGE(PG8_SB(1, 1), cB + hstep + kstep, voffB);
        PG8_WAIT_V(6); PG8_BAR;
    } else {
        PG8_STAGE(PG8_SB(0, 0), cB, voffB); PG8_STAGE(PG8_SA(0, 0), cA, voffA); PG8_STAGE(PG8_SB(0, 1), cB + hstep, voffB); PG8_STAGE(PG8_SA(0, 1), cA + hstep, voffA);
        if (wr == 1) PG8_BAR;
        PG8_WAIT_V(4); PG8_BAR;
        PG8_STAGE(PG8_SB(1, 0), cB + kstep, voffB); PG8_STAGE(PG8_SA(1, 0), cA + kstep, voffA); PG8_STAGE(PG8_SB(1, 1), cB + hstep + kstep, voffB);
        PG8_WAIT_V(6); PG8_BAR;
    }
    for (;;) {
        const bool has_next = S.next(ui + 1, nxt);
        const char* nA = has_next ? (const char*)g.A + (size_t)nxt.pm * tstep : cA; const char* nB = has_next ? (const char*)g.Bt + (size_t)nxt.pn * tstep : cB;
        for (int t = 0; t < nt; t += 2) {
            const bool last = (t == nt - 2);
            const char* a1 = cA + (size_t)(t + 1) * kstep;
            const char* a2 = last ? nA : cA + (size_t)(t + 2) * kstep; const char* b2 = last ? nB : cB + (size_t)(t + 2) * kstep;
            const char* a3 = a2 + kstep; const char* b3 = b2 + kstep;
            if (last && has_next) S.a_ready(nxt);
            if constexpr (SP2) {
            PG8_LDB(B0, 0, 0); PG8_LDB(B1, 0, 1); PG8_SCHED; PG8_LDA(At, 0, 0); PG8_STAGE(PG8_SA(1, 1), a1 + hstep, voffA);
            PG8_WAIT_V(8); PG8_WAIT_L(0); PG8_BAR; PG8_MMA(0, 0, At, B0); PG8_MMA(0, 1, At, B1); PG8_BAR; PG8_SCHED;
            PG8_LDA(At, 0, 1); PG8_STAGE(PG8_SB(0, 0), b2, voffB); PG8_STAGE(PG8_SB(0, 1), b2 + hstep, voffB); PG8_STAGE(PG8_SA(0, 0), a2, voffA);
            PG8_WAIT_V(8); PG8_WAIT_L(0); PG8_BAR; PG8_MMA(1, 0, At, B0); PG8_MMA(1, 1, At, B1); PG8_BAR; PG8_SCHED;
            PG8_LDB(B0, 1, 0); PG8_LDB(B1, 1, 1); PG8_SCHED; PG8_LDA(At, 1, 0); PG8_STAGE(PG8_SA(0, 1), a2 + hstep, voffA);
            PG8_WAIT_V(8); PG8_WAIT_L(0); PG8_BAR; PG8_MMA(0, 0, At, B0); PG8_MMA(0, 1, At, B1); PG8_BAR; PG8_SCHED;
            PG8_LDA(At, 1, 1); PG8_STAGE(PG8_SB(1, 0), b3, voffB); PG8_STAGE(PG8_SB(1, 1), b3 + hstep, voffB); PG8_STAGE(PG8_SA(1, 0), a3, voffA);
            PG8_WAIT_V(8); PG8_WAIT_L(0); PG8_BAR; PG8_MMA(1, 0, At, B0); PG8_MMA(1, 1, At, B1); PG8_BAR; PG8_SCHED;
            } else {
            PG8_LDB(B0, 0, 0); PG8_SCHED; PG8_LDA(At, 0, 0); PG8_STAGE(PG8_SA(1, 1), a1 + hstep, voffA);
            PG8_WAIT_L(8); PG8_BAR; PG8_WAIT_L(0); PG8_MMA(0, 0, At, B0); PG8_BAR; PG8_SCHED;
            PG8_LDB(B1, 0, 1); PG8_STAGE(PG8_SB(0, 0), b2, voffB);
            PG8_BAR; PG8_WAIT_L(0); PG8_MMA(0, 1, At, B1); PG8_BAR;
            PG8_LDA(At, 0, 1); PG8_STAGE(PG8_SA(0, 0), a2, voffA);
            PG8_BAR; PG8_WAIT_L(0); PG8_MMA(1, 0, At, B0); PG8_BAR; PG8_SCHED;
            PG8_STAGE(PG8_SB(0, 1), b2 + hstep, voffB);
            PG8_WAIT_V(6); PG8_BAR; PG8_MMA(1, 1, At, B1); PG8_BAR;
            PG8_LDB(B0, 1, 0); PG8_SCHED; PG8_LDA(At, 1, 0); PG8_STAGE(PG8_SA(0, 1), a2 + hstep, voffA);
            PG8_WAIT_L(8); PG8_BAR; PG8_WAIT_L(0); PG8_MMA(0, 0, At, B0); PG8_BAR; PG8_SCHED;
            PG8_LDB(B1, 1, 1); PG8_STAGE(PG8_SB(1, 0), b3, voffB);
            PG8_BAR; PG8_WAIT_L(0); PG8_MMA(0, 1, At, B1); PG8_BAR;
            PG8_LDA(At, 1, 1); PG8_STAGE(PG8_SA(1, 0), a3, voffA);
            PG8_BAR; PG8_WAIT_L(0); PG8_MMA(1, 0, At, B0); PG8_BAR; PG8_SCHED;
            PG8_STAGE(PG8_SB(1, 1), b3 + hstep, voffB);
            PG8_WAIT_V(6); PG8_BAR; PG8_MMA(1, 1, At, B1); PG8_BAR;
            }
        }
        if constexpr (ALIGN_EPI) { if (wr == 0) PG8_BAR; }
        if constexpr (!Epi::AFTER_DRAIN) { E(acc, cur, wr, wc, fr, fq); S.done(cur); }
        if (!has_next) break;
#pragma unroll
        for (int a = 0; a < 2; ++a)
#pragma unroll
            for (int b = 0; b < 2; ++b)
#pragma unroll
                for (int m = 0; m < 4; ++m)
#pragma unroll
                    for (int n = 0; n < 2; ++n) acc[a][b][m][n] = (f32x4){0.f, 0.f, 0.f, 0.f};
        cur = nxt; cA = nA; cB = nB; ++ui;
        if constexpr (ALIGN_EPI) { if (wr == 1) PG8_BAR; }
    }
    PG8_WAIT_V(0);
    if constexpr (!ALIGN_EPI) { if (wr == 0) PG8_BAR; }
    PG8_BAR;
    if constexpr (Epi::AFTER_DRAIN) { E.fused(acc, cur, wr, wc, fr, fq, lds, wid, lane); S.done(cur); }
#undef PG8_SA
#undef PG8_SB
#undef PG8_STAGE
#undef PG8_LDA
#undef PG8_LDB
#undef PG8_MMA
#undef PG8_WAIT_V
#undef PG8_WAIT_L
#undef PG8_BAR
#undef PG8_SCHED
}
}
namespace attn_body {
using bf16=__hip_bfloat16;
using bf16x8=__attribute__((ext_vector_type(8)))short;
using s16x4=__attribute__((ext_vector_type(4)))short;
using f32x16=__attribute__((ext_vector_type(16)))float;
using u32x4=__attribute__((ext_vector_type(4)))unsigned;
constexpr int BATCH=2,NHEAD=16,SEQ=8192,D=64,DM=NHEAD*D;
constexpr int NW=8,QBLK=32,QB=QBLK*NW,KVBLK=64,NQB=SEQ/QB;
constexpr int ATTN_PITCH=DM, ATTN_UNIT_ROWS=QB;
__device__ __forceinline__ int crow(int r,int hi){return (r&3)+8*(r>>2)+4*hi;}
#define SBAR() __builtin_amdgcn_sched_barrier(0)
__device__ __forceinline__ void cmask(f32x16&p0,f32x16&p1,int jb,int qrel,int hi){
  const float NEG=-INFINITY; int kb=64*jb+4*hi;
  #pragma unroll
  for(int r=0;r<16;++r){int kv=kb+(r&3)+8*(r>>2); if(kv>qrel)p0[r]=NEG; if(kv+32>qrel)p1[r]=NEG;}
}

constexpr int NSLOT=3, SLOTB=8192;
constexpr int LDS_K=0, LDS_V=NSLOT*SLOTB, LDS_WS=2*NSLOT*SLOTB, LDS_OST=LDS_WS+NW*64*4, LDS_BYTES=LDS_OST+NW*4096;
constexpr float C2=0.125f*1.4426950408889634f;
__device__ __forceinline__ void glds16(const void*gsrc,unsigned lds_dst){unsigned keep;
  asm volatile("s_mov_b32 %0, m0\n\ts_mov_b32 m0, %2\n\ts_nop 0\n\tglobal_load_lds_dwordx4 %1, off\n\ts_mov_b32 m0, %0":"=&s"(keep):"v"(gsrc),"s"(lds_dst):"memory");}
__device__ __forceinline__ float max3f(float a,float b,float c){float r;asm("v_max3_f32 %0, %1, %2, %3":"=v"(r):"v"(a),"v"(b),"v"(c));return r;}
__device__ __forceinline__ float max2f(float a,float b){float r;asm("v_max_f32_e32 %0, %1, %2":"=v"(r):"v"(a),"v"(b));return r;}
__device__ __forceinline__ float fadd_s(float a,float b){float r;asm("v_add_f32_e32 %0, %1, %2":"=v"(r):"v"(a),"v"(b));return r;}
__device__ __forceinline__ float fsub_s(float a,float b){float r;asm("v_sub_f32_e32 %0, %1, %2":"=v"(r):"v"(a),"v"(b));return r;}
typedef float f32x2_t __attribute__((ext_vector_type(2))); typedef __bf16 bf16x2_t __attribute__((ext_vector_type(2)));
__device__ __forceinline__ unsigned cvtpk_s(float lo,float hi){f32x2_t v={lo,hi};bf16x2_t b=__builtin_convertvector(v,bf16x2_t);return __builtin_bit_cast(unsigned,b);}
#define WAIT_BAR(N) asm volatile("s_waitcnt vmcnt(" #N ") lgkmcnt(0)\n\ts_barrier":::"memory")

__device__ __forceinline__ void qkt(f32x16&p0,f32x16&p1,const char*Kslot,const bf16x8*qr,const f32x16&negm,int r32,int hi){
  const char*kb=Kslot+hi*1024+r32*16;
  #pragma unroll
  for(int d0=0;d0<4;++d0){
    const bf16x8 b0=*reinterpret_cast<const bf16x8*>(kb+d0*2048);
    const bf16x8 b1=*reinterpret_cast<const bf16x8*>(kb+d0*2048+512);
    if(d0==0){p0=__builtin_amdgcn_mfma_f32_32x32x16_bf16(b0,qr[0],negm,0,0,0);p1=__builtin_amdgcn_mfma_f32_32x32x16_bf16(b1,qr[0],negm,0,0,0);}
    else{p0=__builtin_amdgcn_mfma_f32_32x32x16_bf16(b0,qr[d0],p0,0,0,0);p1=__builtin_amdgcn_mfma_f32_32x32x16_bf16(b1,qr[d0],p1,0,0,0);}}
}
typedef __attribute__((address_space(3))) const char* lds_cptr;
typedef short v4i16_t __attribute__((ext_vector_type(4)));
__device__ __forceinline__ void kload8(bf16x8*kf,lds_cptr kp){
  kf[0]=*(const __attribute__((address_space(3))) bf16x8*)(kp);      kf[1]=*(const __attribute__((address_space(3))) bf16x8*)(kp+512);
  kf[2]=*(const __attribute__((address_space(3))) bf16x8*)(kp+2048); kf[3]=*(const __attribute__((address_space(3))) bf16x8*)(kp+2560);
  kf[4]=*(const __attribute__((address_space(3))) bf16x8*)(kp+4096); kf[5]=*(const __attribute__((address_space(3))) bf16x8*)(kp+4608);
  kf[6]=*(const __attribute__((address_space(3))) bf16x8*)(kp+6144); kf[7]=*(const __attribute__((address_space(3))) bf16x8*)(kp+6656);
}
__device__ __forceinline__ void kload2(bf16x8*kf,lds_cptr kp,int j){ kf[2*j]=*(const __attribute__((address_space(3))) bf16x8*)(kp+j*2048); kf[2*j+1]=*(const __attribute__((address_space(3))) bf16x8*)(kp+j*2048+512); }
__device__ __forceinline__ s16x4 vtr(lds_cptr p){ return __builtin_bit_cast(s16x4,__builtin_amdgcn_ds_read_tr16_b64_v4i16((__attribute__((address_space(3))) v4i16_t*)p)); }
__device__ __forceinline__ float rowmax(const f32x16&p0,const f32x16&p1){
  float a=max3f(p0[0],p0[1],p1[0]),b=max3f(p0[2],p0[3],p1[1]);a=max3f(a,p1[2],p1[3]);
  #pragma unroll
  for(int r=4;r<16;r+=4){a=max3f(a,p0[r],p0[r+1]);b=max3f(b,p0[r+2],p0[r+3]);a=max3f(a,p1[r],p1[r+1]);b=max3f(b,p1[r+2],p1[r+3]);}
  const float m=max2f(a,b);
  auto rr=__builtin_amdgcn_permlane32_swap(__float_as_uint(m),__float_as_uint(m),false,false);
  return max2f(__uint_as_float(rr[0]),__uint_as_float(rr[1]));
}
__device__ __forceinline__ void pv(f32x16*o,int vb,bf16x8 pa0,bf16x8 pa1,bf16x8 pa2,bf16x8 pa3){
  #pragma unroll
  for(int d0=0;d0<2;++d0){s16x4 lo[4],hi[4];
    #pragma unroll
    for(int ks=0;ks<4;++ks){
      asm volatile("ds_read_b64_tr_b16 %0,%1 offset:%c2":"=&v"(lo[ks]):"v"(vb),"i"(d0*4096+ks*1024):"memory");
      asm volatile("ds_read_b64_tr_b16 %0,%1 offset:%c2":"=&v"(hi[ks]):"v"(vb),"i"(d0*4096+ks*1024+512):"memory");}
    asm volatile("s_waitcnt lgkmcnt(0)":::"memory");SBAR();
    #define PK(k) (bf16x8){lo[k][0],lo[k][1],lo[k][2],lo[k][3],hi[k][0],hi[k][1],hi[k][2],hi[k][3]}
    o[d0]=__builtin_amdgcn_mfma_f32_32x32x16_bf16(pa0,PK(0),o[d0],0,0,0);
    o[d0]=__builtin_amdgcn_mfma_f32_32x32x16_bf16(pa1,PK(1),o[d0],0,0,0);
    o[d0]=__builtin_amdgcn_mfma_f32_32x32x16_bf16(pa2,PK(2),o[d0],0,0,0);
    o[d0]=__builtin_amdgcn_mfma_f32_32x32x16_bf16(pa3,PK(3),o[d0],0,0,0);
    #undef PK
  }
}

#ifndef ATTN_STORE16
#define ATTN_STORE16(p,v) (*(u32x4*)(p)=(v))
#endif
template<int THRL> __device__ __forceinline__ void attn_unit(int b,int h,int hv,int qb,const bf16*Q,const bf16*__restrict__ K,const bf16*__restrict__ V,bf16*O,char*shm,const int tid_in){
  const int tid=tid_in,lane=tid&63,r32=lane&31,hi=lane>>5; const int wid=__builtin_amdgcn_readfirstlane(tid>>6);
  const long rowbase=(long)b*SEQ; const int q0=qb*QB;
  const bf16*Qw=Q+(rowbase+q0+wid*QBLK)*DM+h*D;
  const bf16*Kh=K+rowbase*DM+h*D,*Vh=V+rowbase*DM+hv*D;
  const unsigned lds0=(unsigned)(uintptr_t)shm;
  float*wsf=(float*)(shm+LDS_WS)+wid*64;
  const bf16*ksrc=Kh+(long)lane*DM+wid*8;
  const bf16*vsrc=Vh+(long)(16*(wid&3)+(lane>>2))*DM+(wid>>2)*32+(lane&3)*8;
  const unsigned kdst=lds0+LDS_K+wid*1024, vdst=lds0+LDS_V+wid*1024;
  #define DMA_K(t,slot) glds16(ksrc+(long)(t)*KVBLK*DM,(unsigned)__builtin_amdgcn_readfirstlane(kdst+(slot)))
  #define DMA_V(t,slot) glds16(vsrc+(long)(t)*KVBLK*DM,(unsigned)__builtin_amdgcn_readfirstlane(vdst+(slot)))
  const int vb0=(int)(lds0+LDS_V)+((lane>>4)&1)*32+(lane&3)*8+(4*hi+((lane&15)>>2))*64;
  const char*Kbase=shm+LDS_K; bf16x8 kf[8];
  const lds_cptr shm3=(lds_cptr)shm; const lds_cptr kp0=shm3+LDS_K+hi*1024+r32*16; const lds_cptr vp0=shm3+LDS_V+((lane>>4)&1)*32+(lane&3)*8+(4*hi+((lane&15)>>2))*64;
  const int NT=(q0+QB)/KVBLK;
  DMA_K(0,0);DMA_V(0,0);DMA_K(1,SLOTB);
  bf16x8 qr[4];
  #pragma unroll
  for(int d0=0;d0<4;++d0)qr[d0]=*reinterpret_cast<const bf16x8*>(&Qw[(long)r32*DM+d0*16+hi*8]);
  float mhat=0.f,l_reg=0.f;f32x16 o[2];o[0]=f32x16{};o[1]=f32x16{};f32x16 negm=f32x16{};asm volatile("":"+v"(negm));
  const int qrel=wid*QBLK+r32;
  #define CMASK(P0,P1,t) do{int jb_=(t)-(NT-4); if(jb_>=0)cmask(P0,P1,jb_,qrel,hi);}while(0)
  bool resc=false;
  #define START(P0,P1) do{ const float rm=rowmax(P0,P1); resc=false; \
    { const float dl=rm; mhat=fadd_s(mhat,dl); \
      _Pragma("unroll") for(int r=0;r<16;++r){P0[r]=fsub_s(P0[r],dl);P1[r]=fsub_s(P1[r],dl);} \
      _Pragma("unroll") for(int r=0;r<16;++r)negm[r]=-mhat; asm volatile("":"+v"(negm)); } \
    _Pragma("unroll") for(int r=0;r<16;++r)P0[r]=__builtin_amdgcn_exp2f(P0[r]); }while(0)
  #define RESC() do{ if(resc){ asm volatile("s_waitcnt lgkmcnt(0)":::"memory"); \
      _Pragma("unroll") for(int d_=0;d_<2;++d_) _Pragma("unroll") for(int r=0;r<16;++r)o[d_][r]*=wsf[crow(r,hi)]; } }while(0)
  f32x16 pA0,pA1,pB0,pB1;
  int sl_prev=0,sl_cur=0,sl_next=SLOTB;
  #define ROT() do{sl_prev=sl_cur;sl_cur=sl_next;sl_next=(sl_next==(NSLOT-1)*SLOTB)?0:sl_next+SLOTB;}while(0)
  DMA_K(2,2*SLOTB);
  WAIT_BAR(3);
  qkt(pA0,pA1,Kbase,qr,negm,r32,hi);asm volatile("s_nop 15\n\ts_nop 7":"+v"(pA0),"+v"(pA1));CMASK(pA0,pA1,0);
  START(pA0,pA1);
  _Pragma("unroll") for(int r=0;r<16;++r)pA1[r]=__builtin_amdgcn_exp2f(pA1[r]);
  WAIT_BAR(0);
  DMA_K(3,0);DMA_V(1,SLOTB);
  ROT();
  kload8(kf,kp0+sl_cur);
  WAIT_BAR(2);
  s16x4 vlo[8],vhi[8]; u32x4 pw0,pw1,pw2,pw3;
  #define PKW(P,B) cvtpk_s(P[B],P[B+1])
  #define PAF(k) __builtin_bit_cast(bf16x8,pw##k)
  #define VFR(i) (bf16x8){vlo[i][0],vlo[i][1],vlo[i][2],vlo[i][3],vhi[i][0],vhi[i][1],vhi[i][2],vhi[i][3]}
  #define PIN(x) asm volatile("":"+v"(x))
  #define MX3(a,b,c) __builtin_fmaxf(__builtin_fmaxf((a),(b)),(c))
  #define GAPA(MF,A0,A1,A2,A3,W0,W1,PW) do{ MF; sacc+=A0; sacc+=A1; sacc+=A2; sacc+=A3; PIN(sacc); W0; W1; PIN(PW); SBAR(); }while(0)
  #define EX(v) __builtin_amdgcn_exp2f(v)
  #define GAPB(MF,X,B) do{ MF; X[B]=EX(X[B]); X[B+1]=EX(X[B+1]); X[B+2]=EX(X[B+2]); X[B+3]=EX(X[B+3]); PIN(X); SBAR(); }while(0)
  #define VRD(i) do{ vlo[i]=vtr(vp_+(((i)>>2)*4096+((i)&3)*1024)); vhi[i]=vtr(vp_+(((i)>>2)*4096+((i)&3)*1024+512)); }while(0)
  #define KRD(G,j) do{ if(G){ kload2(kf,kp0+sl_next,j); SBAR(); } }while(0)
  #define STEP(C0,C1,P0,P1,t,GK,GV,GL) do{ SBAR(); \
    const lds_cptr vp_=vp0+sl_prev; \
    VRD(0); SBAR(); float sacc=(P0[0]+P0[1]); \
    GAPA(C0=__builtin_amdgcn_mfma_f32_32x32x16_bf16(kf[0],qr[0],negm,0,0,0), P0[2],P0[3],P0[4],P0[5],     pw0[0]=PKW(P0,0), pw0[1]=PKW(P0,2), pw0); \
    VRD(4); SBAR(); GAPA(C1=__builtin_amdgcn_mfma_f32_32x32x16_bf16(kf[1],qr[0],negm,0,0,0), P0[6],P0[7],P0[8],P0[9],     pw0[2]=PKW(P0,4), pw0[3]=PKW(P0,6), pw0); \
    VRD(1); SBAR(); GAPA(C0=__builtin_amdgcn_mfma_f32_32x32x16_bf16(kf[2],qr[1],C0,0,0,0),   P0[10],P0[11],P0[12],P0[13], pw1[0]=PKW(P0,8), pw1[1]=PKW(P0,10), pw1); \
    VRD(5); SBAR(); GAPA(C1=__builtin_amdgcn_mfma_f32_32x32x16_bf16(kf[3],qr[1],C1,0,0,0),   P0[14],P0[15],P1[0],P1[1],   pw1[2]=PKW(P0,12),pw1[3]=PKW(P0,14), pw1); \
    VRD(2); SBAR(); GAPA(C0=__builtin_amdgcn_mfma_f32_32x32x16_bf16(kf[4],qr[2],C0,0,0,0),   P1[2],P1[3],P1[4],P1[5],     pw2[0]=PKW(P1,0), pw2[1]=PKW(P1,2), pw2); \
    VRD(6); SBAR(); GAPA(C1=__builtin_amdgcn_mfma_f32_32x32x16_bf16(kf[5],qr[2],C1,0,0,0),   P1[6],P1[7],P1[8],P1[9],     pw2[2]=PKW(P1,4), pw2[3]=PKW(P1,6), pw2); \
    VRD(3); SBAR(); GAPA(C0=__builtin_amdgcn_mfma_f32_32x32x16_bf16(kf[6],qr[3],C0,0,0,0),   P1[10],P1[11],P1[12],P1[13], pw3[0]=PKW(P1,8), pw3[1]=PKW(P1,10), pw3); \
    VRD(7); SBAR(); GAPA(C1=__builtin_amdgcn_mfma_f32_32x32x16_bf16(kf[7],qr[3],C1,0,0,0),   P1[14],P1[15],0.f,0.f,       pw3[2]=PKW(P1,12),pw3[3]=PKW(P1,14), pw3); \
    l_reg+=sacc; \
    if(GK){DMA_K((t)+3,sl_cur);} if(GV){DMA_V((t)+1,sl_next);} \
    CMASK(C0,C1,t); \
    { float a=MX3(C0[0],C0[1],C1[0]),b=MX3(C0[2],C0[3],C1[1]); a=MX3(a,C1[2],C1[3]); \
      _Pragma("unroll") for(int r=4;r<16;r+=4){a=MX3(a,C0[r],C0[r+1]);b=MX3(b,C0[r+2],C0[r+3]);a=MX3(a,C1[r],C1[r+1]);b=MX3(b,C1[r+2],C1[r+3]);} \
      float rm=__builtin_fmaxf(a,b); { auto rr=__builtin_amdgcn_permlane32_swap(__float_as_uint(rm),__float_as_uint(rm),false,false); rm=__builtin_fmaxf(__uint_as_float(rr[0]),__uint_as_float(rr[1])); } \
      resc=false; \
      if(__builtin_expect(__any(rm>(float)THRL),0)){ const float dl=__builtin_fmaxf(rm,0.f); mhat+=dl; \
        _Pragma("unroll") for(int r=0;r<16;++r){C0[r]-=dl;C1[r]-=dl;} \
        _Pragma("unroll") for(int r=0;r<16;++r)negm[r]=-mhat; asm volatile("":"+v"(negm)); \
        const float f=__builtin_amdgcn_exp2f(-dl); l_reg*=f; if(hi==0)wsf[r32]=f; resc=true; } } \
    SBAR(); \
    GAPB(o[0]=__builtin_amdgcn_mfma_f32_32x32x16_bf16(PAF(0),VFR(0),o[0],0,0,0), C0,0); \
    GAPB(o[1]=__builtin_amdgcn_mfma_f32_32x32x16_bf16(PAF(0),VFR(4),o[1],0,0,0), C0,4); \
    KRD(GL,0); GAPB(o[0]=__builtin_amdgcn_mfma_f32_32x32x16_bf16(PAF(1),VFR(1),o[0],0,0,0), C0,8); \
    KRD(GL,1); GAPB(o[1]=__builtin_amdgcn_mfma_f32_32x32x16_bf16(PAF(1),VFR(5),o[1],0,0,0), C0,12); \
    KRD(GL,2); GAPB(o[0]=__builtin_amdgcn_mfma_f32_32x32x16_bf16(PAF(2),VFR(2),o[0],0,0,0), C1,0); \
    KRD(GL,3); GAPB(o[1]=__builtin_amdgcn_mfma_f32_32x32x16_bf16(PAF(2),VFR(6),o[1],0,0,0), C1,4); \
    GAPB(o[0]=__builtin_amdgcn_mfma_f32_32x32x16_bf16(PAF(3),VFR(3),o[0],0,0,0), C1,8); \
    GAPB(o[1]=__builtin_amdgcn_mfma_f32_32x32x16_bf16(PAF(3),VFR(7),o[1],0,0,0), C1,12); \
    }while(0)
  int t=1;
  #undef CMASK
  #define CMASK(P0,P1,t) do{}while(0)
  for(;t+5<NT;t+=2){
    STEP(pB0,pB1,pA0,pA1,t,true,true,true);     WAIT_BAR(2); RESC(); ROT();
    STEP(pA0,pA1,pB0,pB1,t+1,true,true,true);   WAIT_BAR(2); RESC(); ROT();
  }
  #undef CMASK
  #define CMASK(P0,P1,t) do{int jb_=(t)-(NT-4); if(jb_>=0)cmask(P0,P1,jb_,qrel,hi);}while(0)
  #define ENDW(tt) do{ if((tt)+3<NT){WAIT_BAR(2);} else if((tt)+2<NT){WAIT_BAR(1);} else {WAIT_BAR(0);} }while(0)
  for(;t+1<NT;t+=2){
    STEP(pB0,pB1,pA0,pA1,t,(t+3<NT),(t+1<NT),(t+1<NT));       ENDW(t);   RESC(); ROT();
    STEP(pA0,pA1,pB0,pB1,t+1,(t+4<NT),(t+2<NT),(t+2<NT));     ENDW(t+1); RESC(); ROT();
  }
  STEP(pB0,pB1,pA0,pA1,NT-1,false,false,false); RESC();
  { float sacc=pB0[0]+pB0[1]; _Pragma("unroll") for(int r=2;r<16;++r)sacc+=pB0[r]; _Pragma("unroll") for(int r=0;r<16;++r)sacc+=pB1[r]; l_reg+=sacc;
    pw0=(u32x4){PKW(pB0,0),PKW(pB0,2),PKW(pB0,4),PKW(pB0,6)};pw1=(u32x4){PKW(pB0,8),PKW(pB0,10),PKW(pB0,12),PKW(pB0,14)};pw2=(u32x4){PKW(pB1,0),PKW(pB1,2),PKW(pB1,4),PKW(pB1,6)};pw3=(u32x4){PKW(pB1,8),PKW(pB1,10),PKW(pB1,12),PKW(pB1,14)};
    SBAR(); pv(o,vb0+sl_cur,PAF(0),PAF(1),PAF(2),PAF(3)); }
  #undef PKW
  #undef PAF
  #undef VFR
  #undef PIN
  #undef MX3
  #undef GAPA
  #undef GAPB
  #undef EX
  #undef VRD
  #undef KRD
  #undef STEP
  #undef ENDW
  {auto rr=__builtin_amdgcn_permlane32_swap(__float_as_uint(l_reg),__float_as_uint(l_reg),false,false);l_reg=__uint_as_float(rr[0])+__uint_as_float(rr[1]);}
  if(hi==0)wsf[32+r32]=l_reg;asm volatile("s_waitcnt lgkmcnt(0)":::"memory");
  float rli[16];
  #pragma unroll
  for(int r=0;r<16;++r)rli[r]=__builtin_amdgcn_rcpf(wsf[32+crow(r,hi)]);
  bf16*Ow=O+(rowbase+q0+wid*QBLK)*DM+hv*D;
  { bf16*stg=(bf16*)(shm+LDS_OST)+wid*2048;
    #pragma unroll
    for(int r=0;r<16;++r){const int orow=crow(r,hi);
      #pragma unroll
      for(int d0=0;d0<2;++d0)stg[orow*64+d0*32+r32]=__float2bfloat16(o[d0][r]*rli[r]);}
    asm volatile("s_waitcnt lgkmcnt(0)":::"memory");
    #pragma unroll
    for(int i=0;i<4;++i){const int row=i*8+(lane>>3),ch=lane&7; const u32x4 v=*(const u32x4*)(stg+row*64+ch*8); ATTN_STORE16(Ow+(long)row*DM+ch*8,v);} }
  asm volatile("s_waitcnt lgkmcnt(0)\n\ts_barrier":::"memory");
  #undef DMA_K
  #undef DMA_V
  #undef CMASK
  #undef START
  #undef RESC
  #undef ROT
}
constexpr int ATTN_LDS_BYTES=LDS_BYTES;
#undef SBAR
#undef WAIT_BAR
}
namespace swa {
constexpr int D = 128; constexpr float THR = 8.f; constexpr bool WSKIP = true;
constexpr float SCALE = 0.08838834764831845f;
constexpr int NW = 8, QBLK = 32, KVBLK = 64, QB = NW * QBLK;
constexpr int SHM_V = KVBLK * D * 2, SHM_K = KVBLK * D * 2;
constexpr int LDS_BYTES = 2 * SHM_V + 2 * SHM_K + NW * 64 * 4;
using bf16 = __hip_bfloat16;
typedef short bf16x8 __attribute__((ext_vector_type(8)));
typedef short s16x4 __attribute__((ext_vector_type(4)));
typedef float f32x16 __attribute__((ext_vector_type(16)));
typedef float f32x4 __attribute__((ext_vector_type(4)));
typedef unsigned u32x4 __attribute__((ext_vector_type(4)));
template <class A, class Bt> struct same_t { static constexpr bool v = false; };
template <class A> struct same_t<A, A> { static constexpr bool v = true; };

#define KSWZ(row, colB) ((row) * 256 + ((colB) ^ (((row) & 7) << 4)))
#define SBAR() __builtin_amdgcn_sched_barrier(0)
__device__ __forceinline__ int v_st(int k, int c) { const int kk = (k & ~0xC) | ((k & 4) << 1) | ((k & 8) >> 1); return ((kk >> 3) * 4 + (c >> 5)) * 512 + ((kk & 7) * 32 + (c & 31)) * 2; }
__device__ __forceinline__ int v_rd_base(int lane) { return ((lane & 3) << 3) | (((lane >> 2) & 3) << 6) | (((lane >> 4) & 1) << 5) | (((lane >> 5) & 1) << 8); }
constexpr int v_rd_off(int d0, int ks, int half) { return d0 * 512 + ks * 4096 + half * 2048; }
__device__ __forceinline__ int crow(int r, int hi) { return (r & 3) + 8 * (r >> 2) + 4 * hi; }
__device__ __forceinline__ unsigned cvtpk(float lo, float hi) {
    unsigned r; asm volatile("v_cvt_pk_bf16_f32 %0, %1, %2" : "=v"(r) : "v"(lo), "v"(hi)); return r;
}
__device__ __forceinline__ bf16x8 pack8(f32x4 a, f32x4 b) {
    u32x4 w = {cvtpk(a[0], a[1]), cvtpk(a[2], a[3]), cvtpk(b[0], b[1]), cvtpk(b[2], b[3])};
    return *reinterpret_cast<bf16x8*>(&w);
}
template <class T> __device__ __forceinline__ bf16x8 load8(const T* p) {
    if constexpr (same_t<T, float>::v) { return pack8(*(const f32x4*)p, *(const f32x4*)(p + 4)); }
    else { return *reinterpret_cast<const bf16x8*>(p); }
}
__device__ __forceinline__ void mask_tile(f32x16& p0, f32x16& p1, int dq, unsigned W) {
    const float NEG = -__builtin_inff();
#pragma unroll
    for (int r = 0; r < 16; ++r) {
        const int c = (r & 3) + 8 * (r >> 2);
        if ((unsigned)(dq - c) >= W) p0[r] = NEG;
        if ((unsigned)(dq - c - 32) >= W) p1[r] = NEG;
    }
}
__device__ __forceinline__ void partialSM(f32x16& p0, f32x16& p1, float& m_reg, float& mn, float& alpha) {
    float pmax = p0[0]; for (int r = 1; r < 16; ++r) pmax = fmaxf(pmax, p0[r]); for (int r = 0; r < 16; ++r) pmax = fmaxf(pmax, p1[r]);
    { auto rr = __builtin_amdgcn_permlane32_swap(__float_as_uint(pmax), __float_as_uint(pmax), false, false);
      pmax = fmaxf(__uint_as_float(rr[0]), __uint_as_float(rr[1])); }
    constexpr float C2 = 1.4426950408889634f * SCALE;
    if (__builtin_expect(__all((pmax - m_reg) * SCALE <= THR), 1)) { mn = m_reg; alpha = 1.f; }
    else { mn = fmaxf(m_reg, pmax); alpha = __builtin_amdgcn_exp2f((m_reg - mn) * C2); m_reg = mn; }
    const float mnL = -mn * C2;
    for (int r = 0; r < 16; ++r) p0[r] = fmaf(p0[r], C2, mnL); for (int r = 0; r < 16; ++r) p1[r] = fmaf(p1[r], C2, mnL);
    for (int r = 0; r < 16; ++r) p0[r] = __builtin_amdgcn_exp2f(p0[r]);
}
__device__ __forceinline__ void finishSM(f32x16& p0, f32x16& p1, float alpha, float& l_reg, bf16x8& pa0, bf16x8& pa1, bf16x8& pa2, bf16x8& pa3) {
    for (int r = 0; r < 16; ++r) p1[r] = __builtin_amdgcn_exp2f(p1[r]);
    float ps = 0; for (int r = 0; r < 16; ++r) ps += p0[r]; for (int r = 0; r < 16; ++r) ps += p1[r];
    { auto rr = __builtin_amdgcn_permlane32_swap(__float_as_uint(ps), __float_as_uint(ps), false, false);
      ps = __uint_as_float(rr[0]) + __uint_as_float(rr[1]); }
    l_reg = l_reg * alpha + ps;
#define PK4(P, B_, OUT) do { unsigned a0 = cvtpk(P[B_+0], P[B_+1]), a1 = cvtpk(P[B_+2], P[B_+3]);                          \
        unsigned b0 = cvtpk(P[B_+4], P[B_+5]), b1 = cvtpk(P[B_+6], P[B_+7]);                                             \
        auto r0 = __builtin_amdgcn_permlane32_swap(a0, b0, false, false); auto r1 = __builtin_amdgcn_permlane32_swap(a1, b1, false, false); \
        u32x4 w = {r0[0], r1[0], r0[1], r1[1]}; OUT = *reinterpret_cast<bf16x8*>(&w); } while (0)
    PK4(p0, 0, pa0); PK4(p0, 8, pa1); PK4(p1, 0, pa2); PK4(p1, 8, pa3);
#undef PK4
}
template <int KB, bool SK>
__device__ __forceinline__ void qkt(f32x16& p0, f32x16& p1, const char* K_lds, int r32, int hi, const bf16x8* qr, bool act) {
    if (SK && !act) { const float NEG = -__builtin_inff();
#pragma unroll
        for (int r = 0; r < 16; ++r) { p0[r] = NEG; p1[r] = NEG; } return; }
    p0 = f32x16{}; p1 = f32x16{};
    const char* kb[4];
#pragma unroll
    for (int dd = 0; dd < 4; ++dd) kb[dd] = K_lds + KB * SHM_K + KSWZ(r32, (dd * 16 + hi * 8) * 2);
#pragma unroll
    for (int d0 = 0; d0 < 8; ++d0) { const char* a = kb[d0 & 3] + (d0 >> 2) * 128;
        bf16x8 b0 = *reinterpret_cast<const bf16x8*>(a);
        bf16x8 b1 = *reinterpret_cast<const bf16x8*>(a + 32 * 256);
        p0 = __builtin_amdgcn_mfma_f32_32x32x16_bf16(b0, qr[d0], p0, 0, 0, 0);
        p1 = __builtin_amdgcn_mfma_f32_32x32x16_bf16(b1, qr[d0], p1, 0, 0, 0); }
}
template <int VB, bool SK>
__device__ __forceinline__ void pv_tile(f32x16* o, int vb0, bf16x8 pa0, bf16x8 pa1, bf16x8 pa2, bf16x8 pa3, bool act) {
    if (SK && !act) return;
#define TRRD(dst, off) asm volatile("ds_read_b64_tr_b16 %0, %1 offset:%2" : "=&v"(dst) : "v"(vb0), "i"(off) : "memory")
#define PV_D0(d0) do { s16x4 l0, l1, l2, l3, h0, h1, h2, h3; constexpr int b_ = VB * SHM_V + v_rd_off(d0, 0, 0);     \
        TRRD(l0, b_); TRRD(h0, b_ + 2048); TRRD(l1, b_ + 4096); TRRD(h1, b_ + 6144); TRRD(l2, b_ + 8192); TRRD(h2, b_ + 10240); TRRD(l3, b_ + 12288); TRRD(h3, b_ + 14336); \
        asm volatile("s_waitcnt lgkmcnt(0)" ::: "memory"); SBAR();                 \
        o[d0] = __builtin_amdgcn_mfma_f32_32x32x16_bf16(pa0, (bf16x8){l0[0], l0[1], l0[2], l0[3], h0[0], h0[1], h0[2], h0[3]}, o[d0], 0, 0, 0);   \
        o[d0] = __builtin_amdgcn_mfma_f32_32x32x16_bf16(pa1, (bf16x8){l1[0], l1[1], l1[2], l1[3], h1[0], h1[1], h1[2], h1[3]}, o[d0], 0, 0, 0);   \
        o[d0] = __builtin_amdgcn_mfma_f32_32x32x16_bf16(pa2, (bf16x8){l2[0], l2[1], l2[2], l2[3], h2[0], h2[1], h2[2], h2[3]}, o[d0], 0, 0, 0);   \
        o[d0] = __builtin_amdgcn_mfma_f32_32x32x16_bf16(pa3, (bf16x8){l3[0], l3[1], l3[2], l3[3], h3[0], h3[1], h3[2], h3[3]}, o[d0], 0, 0, 0); } while (0)
    PV_D0(0); PV_D0(1); PV_D0(2); PV_D0(3);
#undef PV_D0
#undef TRRD
}

template <class TIn, class TOut> struct BlockRef { const TIn* Q; const TIn* K; const TIn* V; TOut* O; float* LSE; int P0; int rs; int ls; };
template <class TIn> struct Seam {
    bf16x8 qr[8];
    bf16x8 st_v0, st_v1, st_k0, st_k1; f32x4 sf0, sf1, sf2, sf3;
    f32x4 tq[16];
};
__device__ __forceinline__ int swa_jlo(int P0, int W) { const int lowk = P0 - W + 1; return lowk > 0 ? lowk / KVBLK : 0; }
#define ROW(p, k0, rr, RS) ((p) + ((unsigned)((k0) + (rr)) * (unsigned)(RS) + (unsigned)sc))
#define VMW() asm volatile("s_waitcnt vmcnt(0)" ::: "memory")
#define VMWN(n) asm volatile("s_waitcnt vmcnt(%0)" :: "i"(n) : "memory")
#define SLOAD_H(Kp, Vp, k0, RS) do { S.st_v0 = load8<TIn>(ROW(Vp, k0, sr, RS)); S.st_v1 = load8<TIn>(ROW(Vp, k0, 32 + sr, RS));              \
                         S.st_k0 = load8<TIn>(ROW(Kp, k0, sr, RS)); S.st_k1 = load8<TIn>(ROW(Kp, k0, 32 + sr, RS)); } while (0)
#define SWRITE_HK(bf) do { *(bf16x8*)(K_lds + (bf) * SHM_K + kws) = S.st_k0; *(bf16x8*)(K_lds + (bf) * SHM_K + kws + 32 * 256) = S.st_k1; } while (0)
#define SWRITE_HV(bf) do { *(bf16x8*)(V_lds + (bf) * SHM_V + vst0) = S.st_v0; *(bf16x8*)(V_lds + (bf) * SHM_V + vst1) = S.st_v1; } while (0)
#define SWRITE_H(bf) do { SWRITE_HV(bf); SWRITE_HK(bf); } while (0)
#define SLOAD_F(p, k0) do { S.sf0 = *(const f32x4*)ROW(p, k0, sr, D); S.sf1 = *(const f32x4*)(ROW(p, k0, sr, D) + 4);                \
                            S.sf2 = *(const f32x4*)ROW(p, k0, 32 + sr, D); S.sf3 = *(const f32x4*)(ROW(p, k0, 32 + sr, D) + 4); } while (0)
#define SWRITE_KF(bf) do { *(bf16x8*)(K_lds + (bf) * SHM_K + kws) = pack8(S.sf0, S.sf1); *(bf16x8*)(K_lds + (bf) * SHM_K + kws + 32 * 256) = pack8(S.sf2, S.sf3); } while (0)
#define SWRITE_VF(bf) do { *(bf16x8*)(V_lds + (bf) * SHM_V + vst0) = pack8(S.sf0, S.sf1); *(bf16x8*)(V_lds + (bf) * SHM_V + vst1) = pack8(S.sf2, S.sf3); } while (0)
template <class TIn, class TOut>
__device__ __forceinline__ void causal_swa_prime(const BlockRef<TIn, TOut>& cur, int W, char* lds, Seam<TIn>& S, const int tid_in) {
    constexpr bool F32 = same_t<TIn, float>::v;
    const int tid = tid_in, wid = __builtin_amdgcn_readfirstlane(tid >> 6), lane = tid & 63, r32 = lane & 31, hi = lane >> 5;
    const int sr = tid >> 4, sc = (tid & 15) * 8, kws = KSWZ(sr, sc * 2); char* K_lds = lds + 2 * SHM_V;
    const int kb0 = swa_jlo(cur.P0, W) * KVBLK;
    for (int d0 = 0; d0 < 8; ++d0) S.qr[d0] = load8<TIn>(cur.Q + (unsigned)(wid * QBLK + r32) * (unsigned)cur.rs + d0 * 16 + hi * 8);
    if constexpr (F32) { SLOAD_F((const float*)cur.K, kb0); VMW(); SWRITE_KF(0); SBAR(); SLOAD_F((const float*)cur.V, kb0); }
    else { SLOAD_H(cur.K, cur.V, kb0, cur.rs); VMW(); SWRITE_HK(0); }
    __syncthreads();
}
template <class TIn, class TOut>
__device__ __forceinline__ void causal_swa_block(const BlockRef<TIn, TOut>& cur, const BlockRef<TIn, TOut>& nxt, int skv, int W, char* lds, Seam<TIn>& S, const int tid_in) {
    constexpr bool F32 = same_t<TIn, float>::v;
    const int tid = tid_in, wid = __builtin_amdgcn_readfirstlane(tid >> 6), lane = tid & 63, r32 = lane & 31, hi = lane >> 5;
    const int j_lo = swa_jlo(cur.P0, W);
    int j_hi = (cur.P0 + QB - 1) / KVBLK + 1; if (j_hi > skv / KVBLK) j_hi = skv / KVBLK;
    const int NT = j_hi - j_lo;
    const int kbn = swa_jlo(nxt.P0, W) * KVBLK;
    const int qlo = cur.P0 + wid * QBLK, qm = qlo + r32 - 4 * hi;
    char* V_lds = lds; char* K_lds = lds + 2 * SHM_V;
    float* ws = (float*)(lds + 2 * SHM_V + 2 * SHM_K) + wid * 64; float* li_l = ws, * al_l = ws + 32;
    float m_reg = -1e30f, l_reg = 0; f32x16 o[4] = {};
    const int sr = tid >> 4, sc = (tid & 15) * 8, vst0 = v_st(sr, sc), vst1 = v_st(32 + sr, sc), kws = KSWZ(sr, sc * 2);
    const int vb0 = (int)(uintptr_t)V_lds + v_rd_base(lane);
    const TIn* Kh = cur.K; const TIn* Vh = cur.V;
#define RESC(a) do { if (__any((a) < 1.f)) { if (hi == 0) al_l[r32] = (a); asm volatile("s_waitcnt lgkmcnt(0)" ::: "memory");              \
                     for (int d_ = 0; d_ < 4; ++d_) for (int r = 0; r < 16; ++r) o[d_][r] *= al_l[crow(r, hi)]; } } while (0)
#define KBASE(t) ((j_lo + (t)) * KVBLK)
#define ACT(t) (KBASE(t) <= qlo + QBLK - 1 && KBASE(t) + KVBLK - 1 >= qlo - W + 1)
#define MASKT(P0_, P1_, t) do { const int kb_ = KBASE(t); if ((!SK || ACT(t)) && (kb_ + KVBLK - 1 > qlo || kb_ <= qlo + QBLK - 1 - W)) mask_tile(P0_, P1_, qm - kb_, (unsigned)W); } while (0)
    constexpr int NQL = F32 ? 16 : 8;
    constexpr bool SK = WSKIP && !F32;
#define SEAM_K0() do { VMWN(NQL); if constexpr (F32) { SWRITE_KF(0); SBAR(); SLOAD_F((const float*)nxt.V, kbn); } else { SWRITE_HK(0); } SBAR(); } while (0)
    f32x16 pA0, pA1, pB0, pB1; float mnA, mnB, alA, alB; bf16x8 pa0, pa1, pa2, pa3;
    if constexpr (F32) { VMW(); SWRITE_VF(0); SBAR(); } else { SWRITE_HV(0); SBAR(); }
    if (NT > 1) { if constexpr (F32) SLOAD_F((const float*)Kh, KBASE(1)); else SLOAD_H(Kh, Vh, KBASE(1), cur.rs); }
    SBAR(); qkt<0, SK>(pA0, pA1, K_lds, r32, hi, S.qr, ACT(0));
    if constexpr (F32) { if (NT > 1) { VMW(); SWRITE_KF(1); SBAR(); SLOAD_F((const float*)Vh, KBASE(1)); } }
    MASKT(pA0, pA1, 0); partialSM(pA0, pA1, m_reg, mnA, alA);
    if (NT > 1) { VMW(); if constexpr (F32) { SWRITE_VF(1); SBAR(); if (NT > 2) SLOAD_F((const float*)Kh, KBASE(2)); } else SWRITE_H(1); }
    __syncthreads();
#define HALF_STEP(PX0, PX1, mnX, alX, PY0, PY1, alY, t, KB, VB, SB) do {                                                      \
        SBAR(); qkt<KB, SK>(PX0, PX1, K_lds, r32, hi, S.qr, ACT(t));                                             \
        finishSM(PY0, PY1, alY, l_reg, pa0, pa1, pa2, pa3); SBAR();                                                           \
        if ((t) + 1 < NT) { if constexpr (F32) { VMW(); SWRITE_KF(SB); SBAR(); SLOAD_F((const float*)Vh, KBASE((t) + 1)); }  \
                            else { SLOAD_H(Kh, Vh, KBASE((t) + 1), cur.rs); } SBAR(); }                                               \
        pv_tile<VB, SK>(o, vb0, pa0, pa1, pa2, pa3, ACT((t) - 1)); MASKT(PX0, PX1, (t)); partialSM(PX0, PX1, m_reg, mnX, alX);                                        \
        __syncthreads();                                                                                                      \
        if ((t) + 1 < NT) { VMW(); if constexpr (F32) { SWRITE_VF(SB); SBAR(); if ((t) + 2 < NT) SLOAD_F((const float*)Kh, KBASE((t) + 2)); } \
                            else { SWRITE_H(SB); } }                                                                          \
        RESC(alX); __syncthreads(); } while (0)
    for (int t = 1; t + 1 < NT; t += 2) {
        HALF_STEP(pB0, pB1, mnB, alB, pA0, pA1, alA, t, 1, 0, 0);
        HALF_STEP(pA0, pA1, mnA, alA, pB0, pB1, alB, t + 1, 0, 1, 1);
    }
    const bool even = (NT & 1) == 0;
    if (even) { SBAR(); qkt<1, SK>(pB0, pB1, K_lds, r32, hi, S.qr, ACT(NT - 1)); SBAR(); }
#define QROW(e) (nxt.Q + (size_t)(wid * QBLK + r32) * D + ((e) >> 1) * 16 + hi * 8 + ((e) & 1) * 4)
    if constexpr (F32) { SLOAD_F((const float*)nxt.K, kbn); SBAR();
#pragma unroll
        for (int e = 0; e < 8; ++e) S.tq[e] = *(const f32x4*)QROW(e); }
    else { SLOAD_H(nxt.K, nxt.V, kbn, nxt.rs); SBAR();
#pragma unroll
        for (int d0 = 0; d0 < 8; ++d0) S.qr[d0] = load8<TIn>(nxt.Q + (unsigned)(wid * QBLK + r32) * (unsigned)nxt.rs + d0 * 16 + hi * 8); }
    SBAR();
    finishSM(pA0, pA1, alA, l_reg, pa0, pa1, pa2, pa3); SBAR();
    if constexpr (F32) {
#pragma unroll
        for (int e = 8; e < 16; ++e) S.tq[e] = *(const f32x4*)QROW(e); SBAR(); }
#undef QROW
    pv_tile<0, SK>(o, vb0, pa0, pa1, pa2, pa3, ACT(even ? NT - 2 : NT - 1));
    if (even) { MASKT(pB0, pB1, NT - 1); partialSM(pB0, pB1, m_reg, mnB, alB); __syncthreads(); RESC(alB);
        finishSM(pB0, pB1, alB, l_reg, pa0, pa1, pa2, pa3); SBAR(); pv_tile<1, SK>(o, vb0, pa0, pa1, pa2, pa3, ACT(NT - 1)); }
    SBAR(); SEAM_K0();
    if (hi == 0) li_l[r32] = l_reg; asm volatile("s_waitcnt lgkmcnt(0)" ::: "memory");
    float rli[16];
#pragma unroll
    for (int r = 0; r < 16; ++r) rli[r] = __builtin_amdgcn_rcpf(li_l[crow(r, hi)]);
    TOut* Ow = cur.O + (unsigned)(wid * QBLK) * (unsigned)cur.rs;
    if (hi == 0) cur.LSE[(unsigned)(wid * QBLK + r32) * (unsigned)cur.ls] = m_reg * SCALE + __logf(l_reg);
#pragma unroll
    for (int r = 0; r < 16; ++r) { const int orow = crow(r, hi);
#pragma unroll
        for (int d0 = 0; d0 < 4; ++d0) { const float v = o[d0][r] * rli[r];
            if constexpr (same_t<TOut, float>::v) { Ow[(unsigned)orow * (unsigned)cur.rs + d0 * 32 + r32] = v; }
            else { const float vn = __shfl_xor(v, 1);
                   if ((r32 & 1) == 0) *(unsigned*)(Ow + (unsigned)orow * (unsigned)cur.rs + d0 * 32 + r32) = cvtpk(v, vn); } } }
    if constexpr (F32) {
#pragma unroll
        for (int d0 = 0; d0 < 8; ++d0) S.qr[d0] = pack8(S.tq[2 * d0], S.tq[2 * d0 + 1]); }
    __syncthreads();
#undef RESC
#undef KBASE
#undef ACT
#undef MASKT
#undef SEAM_K0
#undef HALF_STEP
}
#undef ROW
#undef VMW
#undef VMWN
#undef SLOAD_H
#undef SWRITE_HK
#undef SWRITE_HV
#undef SWRITE_H
#undef SLOAD_F
#undef SWRITE_KF
#undef SWRITE_VF
}
#define LAS __attribute__((address_space(3)))
#define RLX_AGENT __ATOMIC_RELAXED, __HIP_MEMORY_SCOPE_AGENT
#define XB_TMO      128
#define XB_XCNT(j)  (256  + 64 * (j))
#define XB_XSUB(j)  (1280 + 64 * (j))
#define XB_XGEN(j)  (2304 + 64 * (j))
#define XB_TOP      3328
#define XB_TOPGEN   3392
#define XCD_BAR_WORDS 3456
#define XB_SPIN_CAP (1u << 18)

__device__ __forceinline__ unsigned xb_ld(unsigned* p)              { return __hip_atomic_load(p, __ATOMIC_RELAXED, __HIP_MEMORY_SCOPE_AGENT); }
__device__ __forceinline__ unsigned xb_add(unsigned* p, unsigned v) { return __hip_atomic_fetch_add(p, v, __ATOMIC_RELAXED, __HIP_MEMORY_SCOPE_AGENT); }
__device__ __forceinline__ unsigned xb_xcc_id() { return (unsigned)__builtin_amdgcn_s_getreg((3 << 11) | 20) & 0xFu; }
#define XB_SPIN(cond, bar) do { unsigned _sp = 0; while (cond) { __builtin_amdgcn_s_sleep(1); \
    if ((++_sp & 255u) == 0u) { if (xb_ld(&(bar)[XB_TMO])) break; if (_sp > XB_SPIN_CAP) { atomicAdd(&(bar)[XB_TMO], 1u); break; } } } } while (0)

struct XcdBarrier {
    unsigned* bar; unsigned x;
    volatile LAS unsigned* st;
};

__device__ __forceinline__ XcdBarrier xcd_barrier_post(unsigned* bar, volatile LAS unsigned* st, const int tid) {
    XcdBarrier b; b.bar = bar; b.x = xb_xcc_id(); b.st = st;
    if (tid == 0) (void)xb_add(&bar[XB_XCNT(b.x)], 1u);
    return b;
}
__device__ __forceinline__ void xcd_barrier_complete(unsigned* bar, unsigned x, unsigned& nloc, unsigned& nx) {
    const unsigned G = gridDim.x * gridDim.y * gridDim.z;
    unsigned sum, cnt, mine, sp = 0u;
    for (;;) {
        sum = 0u; cnt = 0u; mine = 0u;
#pragma unroll
        for (unsigned j = 0; j < 16; ++j) { const unsigned c = xb_ld(&bar[XB_XCNT(j)]); sum += c; cnt += (c > 0u) ? 1u : 0u; mine = (j == x) ? c : mine; }
        if (sum == G) break;
        __builtin_amdgcn_s_sleep(1);
        if ((++sp & 255u) == 0u) { if (xb_ld(&bar[XB_TMO])) break; if (sp > XB_SPIN_CAP) { atomicAdd(&bar[XB_TMO], 1u); break; } }
    }
    nloc = mine > 0u ? mine : 1u; nx = cnt > 0u ? cnt : 1u;
}

__device__ __forceinline__ void xcd_barrier(const XcdBarrier& b, const int tid) {
    asm volatile("s_waitcnt vmcnt(0)" ::: "memory");
    __syncthreads();
    if (tid == 0) {
        unsigned* bar = b.bar;
        __builtin_amdgcn_s_waitcnt(0);
        unsigned nloc = b.st[0], nx = b.st[1];
        if (nloc == 0u) { xcd_barrier_complete(bar, b.x, nloc, nx); b.st[0] = nloc; b.st[1] = nx; }
        const unsigned old = xb_add(&bar[XB_XSUB(b.x)], 1u);
        const unsigned gen = old / nloc;
        if (old + 1u == (gen + 1u) * nloc) {
            __builtin_amdgcn_fence(__ATOMIC_RELEASE, "agent");
            asm volatile("s_waitcnt vmcnt(0)" ::: "memory");
            const unsigned og = xb_add(&bar[XB_TOP], 1u);
            const unsigned tg = og / nx;
            if (og + 1u == (tg + 1u) * nx) xb_add(&bar[XB_TOPGEN], 1u);
            else XB_SPIN(xb_ld(&bar[XB_TOPGEN]) == tg, bar);
            __builtin_amdgcn_fence(__ATOMIC_ACQUIRE, "agent");
            xb_add(&bar[XB_XGEN(b.x)], 1u);
            asm volatile("s_waitcnt vmcnt(0)" ::: "memory");
        } else {
            XB_SPIN(xb_ld(&bar[XB_XGEN(b.x)]) == gen, bar);
            __builtin_amdgcn_fence(__ATOMIC_ACQUIRE, "agent");
            asm volatile("s_waitcnt vmcnt(0)" ::: "memory");
        }
    }
    __syncthreads();
}

namespace cg = cooperative_groups;
constexpr int NWAVES = 8;
constexpr int BATCH = 2, SEQ = 8192, DM = 2048, T = BATCH * SEQ, NIN = 6144, DFF = 5632, NGU = 2 * DFF, NMOD = 6 * DM;
constexpr float RMS_EPS = 1e-6f;
constexpr size_t MiB = 1u << 20;
constexpr size_t WS_MOD = 1 * MiB, WS_SSQ = 2 * MiB, WS_LSE = 4 * MiB, WS_CSA = 6 * MiB, WS_CSB = 14 * MiB;
constexpr size_t WS_WIN = 18 * MiB, WS_WOUT = 42 * MiB, WS_WGU = 50 * MiB, WS_WDN = 94 * MiB;
constexpr size_t WS_H = 116 * MiB, WS_OB0 = 116 * MiB, WS_OB1 = 148 * MiB, WS_H2 = 116 * MiB;
constexpr size_t WS_R = 180 * MiB;
constexpr size_t WS_QA = WS_R, WS_KA = WS_R + 32 * MiB, WS_VA = WS_R + 64 * MiB, WS_QB = WS_R + 96 * MiB, WS_KB = WS_R + 128 * MiB, WS_VB = WS_R + 160 * MiB;
constexpr size_t WS_OA = WS_R + 192 * MiB;
constexpr size_t WS_MIX = WS_R, WS_Y = WS_R + 64 * MiB, WS_ACT = WS_R, WS_F = WS_R + 176 * MiB, WS_END = WS_R + 304 * MiB;
constexpr int LDS_BYTES = 147456;

typedef unsigned short bf16;
typedef unsigned v4u __attribute__((ext_vector_type(4)));
typedef unsigned v2u __attribute__((ext_vector_type(2)));
typedef float f32x4 __attribute__((ext_vector_type(4)));
#define LAS __attribute__((address_space(3)))
#define LDS_WAIT() asm volatile("s_waitcnt lgkmcnt(0)" ::: "memory")
__device__ __forceinline__ unsigned f2bf(float f) { unsigned u = __builtin_bit_cast(unsigned, f); return (u + 0x7fffu + ((u >> 16) & 1u)) >> 16; }
__device__ __forceinline__ unsigned pk2(float lo, float hi) { return f2bf(lo) | (f2bf(hi) << 16); }
__device__ __forceinline__ float bflo(unsigned w) { return __builtin_bit_cast(float, w << 16); }
__device__ __forceinline__ float bfhi(unsigned w) { return __builtin_bit_cast(float, w & 0xffff0000u); }
__device__ __forceinline__ float wave_sum(float v) {
#pragma unroll
    for (int o = 1; o < 64; o <<= 1) v += __shfl_xor(v, o);
    return v;
}
__device__ __forceinline__ float sum16(float v) { v += __shfl_xor(v, 1); v += __shfl_xor(v, 2); v += __shfl_xor(v, 4); v += __shfl_xor(v, 8); return v; }

__device__ const double INV_FREQ[64] = {
  1.0, 0.8659643233600653, 0.7498942093324559, 0.6493816315762113,
  0.5623413251903491, 0.4869675251658631, 0.4216965034285822, 0.3651741272548377,
  0.31622776601683794, 0.27384196342643613, 0.23713737056616552, 0.2053525026457146,
  0.1778279410038923, 0.1539926526059492, 0.1333521432163324, 0.11547819846894582,
  0.1, 0.08659643233600653, 0.07498942093324558, 0.06493816315762113,
  0.05623413251903491, 0.04869675251658631, 0.042169650342858224, 0.03651741272548377,
  0.03162277660168379, 0.027384196342643614, 0.023713737056616554, 0.02053525026457146,
  0.01778279410038923, 0.01539926526059492, 0.01333521432163324, 0.011547819846894581,
  0.01, 0.008659643233600654, 0.007498942093324558, 0.006493816315762113,
  0.005623413251903491, 0.004869675251658631, 0.004216965034285823, 0.003651741272548377,
  0.0031622776601683794, 0.0027384196342643613, 0.0023713737056616554, 0.002053525026457146,
  0.0017782794100389228, 0.001539926526059492, 0.001333521432163324, 0.0011547819846894581,
  0.001, 0.0008659643233600654, 0.0007498942093324559, 0.0006493816315762113,
  0.0005623413251903491, 0.0004869675251658631, 0.00042169650342858224, 0.0003651741272548377,
  0.00031622776601683794, 0.0002738419634264361, 0.00023713737056616554, 0.0002053525026457146,
  0.00017782794100389227, 0.0001539926526059492, 0.0001333521432163324, 0.00011547819846894582,
};
__device__ __forceinline__ void sincos_d(double a, float& co, float& si) {
    const double k = __builtin_rint(a * 0.63661977236758134308);
    double r = __builtin_fma(-k, 1.57079632679489655800e+00, a); r = __builtin_fma(-k, 6.12323399573676603587e-17, r);
    const double r2 = r * r;
    double sp = 1.0 / 6227020800.0; sp = sp * r2 - 1.0 / 39916800.0; sp = sp * r2 + 1.0 / 362880.0; sp = sp * r2 - 1.0 / 5040.0; sp = sp * r2 + 1.0 / 120.0; sp = sp * r2 - 1.0 / 6.0;
    const double sn = r + r * r2 * sp;
    double cp = -1.0 / 87178291200.0; cp = cp * r2 + 1.0 / 479001600.0; cp = cp * r2 - 1.0 / 3628800.0; cp = cp * r2 + 1.0 / 40320.0; cp = cp * r2 - 1.0 / 720.0; cp = cp * r2 + 1.0 / 24.0; cp = cp * r2 - 0.5;
    const double cs = 1.0 + r2 * cp;
    const int q = ((int)k) & 3;
    const double c = (q == 0) ? cs : (q == 1) ? -sn : (q == 2) ? -cs : sn;
    const double s = (q == 0) ? sn : (q == 1) ? cs : (q == 2) ? -sn : -cs;
    co = (float)c; si = (float)s;
}

struct Args { const float* in[20]; float* out; unsigned char* ws; };
enum { I_X = 0, I_C, I_POS, I_WADA, I_BADA, I_GPREA, I_WIN, I_GOUTA, I_LQ1, I_LK1, I_LQ2, I_LK2, I_GSUB, I_WOUT, I_GPOSTA, I_GPREF, I_WGATE, I_WUP, I_WDOWN, I_GPOSTF };

__device__ __forceinline__ void transpose_item(const float* W, int K, int N, bf16* WT, int dst_row0, int k0, int n0, LAS float* scr, int lane) {
#pragma unroll
    for (int i = 0; i < 8; ++i) { const int kk = 8 * i + (lane >> 3), c4 = (lane & 7) * 4; const f32x4 v = *(const f32x4*)(W + (size_t)(k0 + kk) * N + n0 + c4);
        LAS float* d = scr + kk * 33 + c4; d[0] = v[0]; d[1] = v[1]; d[2] = v[2]; d[3] = v[3]; }
    LDS_WAIT(); asm volatile("" ::: "memory");
    const int c = lane & 7;
#pragma unroll
    for (int j = 0; j < 4; ++j) { const int n = (lane >> 3) + 8 * j; const LAS float* s = scr + (8 * c) * 33 + n;
        v4u o; o.x = pk2(s[0 * 33], s[1 * 33]); o.y = pk2(s[2 * 33], s[3 * 33]); o.z = pk2(s[4 * 33], s[5 * 33]); o.w = pk2(s[6 * 33], s[7 * 33]);
        *(v4u*)(WT + (size_t)(dst_row0 + n) * K + k0 + 8 * c) = o; }
    LDS_WAIT(); asm volatile("" ::: "memory");
}
__device__ __forceinline__ int win_dst_row(int n0) {
    const int pn = n0 >> 8, loc = n0 & 255, kind = pn >> 2; int nl = loc;
    if (kind == 0 || kind == 1) nl = 128 * ((loc >> 6) & 1) + 64 * (loc >> 7) + (loc & 63);
    else if (kind == 3 || kind == 4) nl = 128 * ((loc >> 5) & 1) + 32 * (loc >> 6) + (loc & 31);
    return pn * 256 + nl;
}

#define AIN(i) ((const float*)kargs_[(i)])
#define PHASE_PTRS() \
    typedef const void* __attribute__((address_space(4))) const kargp_t; kargp_t* kargs_ = (kargp_t*)__builtin_amdgcn_kernarg_segment_ptr(); asm volatile("" : "+s"(kargs_)); \
    unsigned char* ws = (unsigned char*)kargs_[21]; \
    int lz_ = 0; asm volatile("" : "+v"(lz_)); const int lane = (int)__builtin_amdgcn_mbcnt_hi(~0u, __builtin_amdgcn_mbcnt_lo(~0u, (unsigned)lz_)); const int wave = wave_s, tid = wave_s * 64 + lane; \
    const int G = gridDim.x, bx = blockIdx.x; const int vcu = (bx % 8) * (G / 8) + bx / 8; \
    const int gw = bx * NWAVES + wave, NGW = G * NWAVES; (void)vcu; (void)gw; (void)NGW; (void)lane; \
    const float* x = AIN(I_X); \
    float* MOD = (float*)(ws + WS_MOD); float* SSQ = (float*)(ws + WS_SSQ); float* LSE = (float*)(ws + WS_LSE); \
    float* CSA = (float*)(ws + WS_CSA); float* CSB = (float*)(ws + WS_CSB); \
    bf16* WIN = (bf16*)(ws + WS_WIN); bf16* WOUT = (bf16*)(ws + WS_WOUT); bf16* WGU = (bf16*)(ws + WS_WGU); bf16* WDN = (bf16*)(ws + WS_WDN); \
    bf16* HB = (bf16*)(ws + WS_H); bf16* H2 = (bf16*)(ws + WS_H2); bf16* OB0 = (bf16*)(ws + WS_OB0); bf16* OB1 = (bf16*)(ws + WS_OB1); \
    bf16* QA = (bf16*)(ws + WS_QA); bf16* KA = (bf16*)(ws + WS_KA); bf16* VA = (bf16*)(ws + WS_VA); \
    bf16* QB = (bf16*)(ws + WS_QB); bf16* KB = (bf16*)(ws + WS_KB); bf16* VB = (bf16*)(ws + WS_VB); \
    bf16* OA = (bf16*)(ws + WS_OA); bf16* MIX = (bf16*)(ws + WS_MIX); float* Y = (float*)(ws + WS_Y); bf16* ACT = (bf16*)(ws + WS_ACT); float* F = (float*)(ws + WS_F); \
    (void)0
struct DiffUnit { int b, hq, hv, qb, m; };
struct DiffSched { int vcu;
  __device__ __forceinline__ bool next(int i, DiffUnit& u) const { if (i >= 8) return false; const int s = vcu & 15, bh = vcu >> 4; u.b = bh >> 3; const int h = bh & 7; u.m = (i >> 1) & 1; u.hq = u.m * 8 + h; u.hv = 2 * h + (i & 1); u.qb = (i & 4) ? 31 - s : s; return true; } };
#define RUNS(lo, hi, k) ((k) >= (lo) && (k) <= (hi))
#define RUN(k) (MODE == 0 || (MODE == 1 && RUNS(0, 2, k)) || (MODE == 2 && (k) == 3) || (MODE == 3 && (k) == 4) || (MODE == 4 && RUNS(5, 10, k)))
#define SYNC(k) (MODE == 0 || (MODE == 1 && (k) < 2) || (MODE == 4 && (k) >= 5))
constexpr int LDS_BARST = LDS_BYTES - 64;
#define GRID_BAR() do { int lzb_ = 0; asm volatile("" : "+v"(lzb_)); const int lane_b = (int)__builtin_amdgcn_mbcnt_hi(~0u, __builtin_amdgcn_mbcnt_lo(~0u, (unsigned)lzb_)); typedef const void* __attribute__((address_space(4))) const kargq_t; kargq_t* kq_ = (kargq_t*)__builtin_amdgcn_kernarg_segment_ptr(); asm volatile("" : "+s"(kq_)); \
    XcdBarrier b_; b_.bar = (unsigned*)kq_[21]; b_.x = xb_xcc_id(); b_.st = (volatile LAS unsigned*)((LAS unsigned char*)lds + LDS_BARST); xcd_barrier(b_, wave_s * 64 + lane_b); } while (0)
template <int MODE> __global__ void __launch_bounds__(NWAVES * 64, 2) fwd_megakernel(Args args) {
    extern __shared__ __attribute__((aligned(16))) unsigned char lds[];
    int wave_s;
    {
        const int tid0 = threadIdx.x;
        wave_s = __builtin_amdgcn_readfirstlane(tid0 >> 6); asm volatile("" : "+s"(wave_s));
        if constexpr (MODE == 0 || MODE == 1 || MODE == 4) {
            unsigned* barw = (unsigned*)args.ws;
            if (blockIdx.x == 0) for (int i = tid0; i < XCD_BAR_WORDS; i += NWAVES * 64) __hip_atomic_store(barw + i, 0u, __ATOMIC_RELAXED, __HIP_MEMORY_SCOPE_AGENT);
            if (tid0 < 2) ((volatile LAS unsigned*)((LAS unsigned char*)lds + LDS_BARST))[tid0] = 0u;
            __threadfence();
            cooperative_groups::this_grid().sync();
            (void)xcd_barrier_post(barw, (volatile LAS unsigned*)((LAS unsigned char*)lds + LDS_BARST), tid0);
        }
    }
    if constexpr (RUN(0)) {
        PHASE_PTRS();
        const bool split = G >= 96; const int nada = 48;
        if (!split || bx < nada) {
            for (int chunk = bx; chunk < nada; chunk += (split ? nada : G)) {
                LAS float* sil = (LAS float*)lds; LAS float* red = (LAS float*)(lds + 16384);
                const float* cv = AIN(I_C);
                for (int i = tid; i < 2 * DM; i += NWAVES * 64) { const float c = cv[i]; sil[i] = c / (1.0f + __expf(-c)); }
                __syncthreads();
                const float* wa = AIN(I_WADA) + chunk * 256 + 4 * lane;
                f32x4 a0 = {0.f, 0.f, 0.f, 0.f}, a1 = {0.f, 0.f, 0.f, 0.f};
                const int kbeg = wave * 256;
#pragma unroll 1
                for (int k = kbeg; k < kbeg + 256; k += 8) {
                    f32x4 w[8];
#pragma unroll
                    for (int j = 0; j < 8; ++j) w[j] = *(const f32x4*)(wa + (size_t)(k + j) * NMOD);
#pragma unroll
                    for (int j = 0; j < 8; ++j) { const float s0 = sil[k + j], s1 = sil[DM + k + j]; a0 += w[j] * s0; a1 += w[j] * s1; }
                }
#pragma unroll
                for (int i = 0; i < 4; ++i) { red[(wave * 2 + 0) * 256 + 4 * lane + i] = a0[i]; red[(wave * 2 + 1) * 256 + 4 * lane + i] = a1[i]; }
                __syncthreads();
                { const int b = tid >> 8, c = tid & 255; float s = 0.f;
#pragma unroll
                  for (int w8 = 0; w8 < 8; ++w8) s += red[(w8 * 2 + b) * 256 + c];
                  MOD[b * NMOD + chunk * 256 + c] = s + AIN(I_BADA)[chunk * 256 + c]; }
                __syncthreads();
            }
        }
        if (!split || bx >= nada) {
            const int cb = split ? bx - nada : bx, CG = split ? G - nada : G;
            const int cw = cb * NWAVES + wave, NCW = CG * NWAVES;
            LAS float* scr = (LAS float*)(lds + 32768 + wave * 8704);
            constexpr int I_IN = (DM / 64) * (NIN / 32), I_OUT = (DM / 64) * (DM / 32), I_G = (DM / 64) * (DFF / 32), I_D = (DFF / 64) * (DM / 32);
            constexpr int NITEMS = I_IN + I_OUT + 2 * I_G + I_D;
#pragma unroll 1
            for (int it = cw; it < NITEMS; it += NCW) {
                int r = it;
                if (r < I_IN) { const int nb = NIN / 32, kb = r / nb, n0 = (r % nb) * 32; transpose_item(AIN(I_WIN), DM, NIN, WIN, win_dst_row(n0), kb * 64, n0, scr, lane); continue; } r -= I_IN;
                if (r < I_OUT) { const int nb = DM / 32, kb = r / nb, n0 = (r % nb) * 32; transpose_item(AIN(I_WOUT), DM, DM, WOUT, n0, kb * 64, n0, scr, lane); continue; } r -= I_OUT;
                if (r < I_G) { const int nb = DFF / 32, kb = r / nb, n0 = (r % nb) * 32; transpose_item(AIN(I_WGATE), DM, DFF, WGU, (n0 >> 7) * 256 + (n0 & 127), kb * 64, n0, scr, lane); continue; } r -= I_G;
                if (r < I_G) { const int nb = DFF / 32, kb = r / nb, n0 = (r % nb) * 32; transpose_item(AIN(I_WUP), DM, DFF, WGU, (n0 >> 7) * 256 + 128 + (n0 & 127), kb * 64, n0, scr, lane); continue; } r -= I_G;
                { const int nb = DM / 32, kb = r / nb, n0 = (r % nb) * 32; transpose_item(AIN(I_WDOWN), DFF, DM, WDN, n0, kb * 64, n0, scr, lane); }
            }
            const int* pos = (const int*)AIN(I_POS);
            const int ct = cb * (NWAVES * 64) + tid, NCT = CG * NWAVES * 64;
#pragma unroll 1
            for (int i = ct; i < T * 96; i += NCT) {
                if (i < T * 64) { const int t = i >> 6, e = i & 63; float co, si; sincos_d((double)pos[t] * INV_FREQ[e], co, si); *(float2*)(CSA + (size_t)i * 2) = make_float2(co, si); }
                else { const int i2 = i - T * 64, t = i2 >> 5, e = i2 & 31; float co, si; sincos_d((double)pos[t] * INV_FREQ[2 * e], co, si); *(float2*)(CSB + (size_t)i2 * 2) = make_float2(co, si); }
            }
        }
        if constexpr (SYNC(0)) GRID_BAR();
    }

    if constexpr (RUN(1)) {
        PHASE_PTRS();
        const float* g = AIN(I_GPREA);
#pragma unroll 1
        for (int m = gw; m < T; m += NGW) {
            const int b = m >> 13; const float* xr = x + (size_t)m * DM + 4 * lane; const float* sh = MOD + b * NMOD + 4 * lane; const float* sc = sh + DM;
            f32x4 v[8]; float ss = 0.f;
#pragma unroll
            for (int j = 0; j < 8; ++j) { v[j] = *(const f32x4*)(xr + 256 * j); ss += (v[j][0] * v[j][0] + v[j][1] * v[j][1]) + (v[j][2] * v[j][2] + v[j][3] * v[j][3]); }
            const float rstd = 1.0f / sqrtf(wave_sum(ss) * (1.0f / DM) + RMS_EPS);
            bf16* hr = HB + (size_t)m * DM + 4 * lane;
#pragma unroll
            for (int j = 0; j < 8; ++j) { const f32x4 gg = *(const f32x4*)(g + 4 * lane + 256 * j), s1 = *(const f32x4*)(sc + 256 * j), s0 = *(const f32x4*)(sh + 256 * j);
                const f32x4 o = (v[j] * rstd) * gg * (s1 + 1.0f) + s0; v2u w; w.x = pk2(o[0], o[1]); w.y = pk2(o[2], o[3]); *(v2u*)(hr + 256 * j) = w; }
        }
        if constexpr (SYNC(1)) GRID_BAR();
    }

    if constexpr (RUN(2)) {
        PHASE_PTRS();
        pg8::Gemm gm{HB, WIN, T, NIN, DM}; pg8::StaticOrder S; S.init(T, NIN, G, bx);
        pg8::EpiInProj E{ws, attn_body::C2};
        static_assert(WS_CSA == pg8::EpiInProj::O_CSA && WS_CSB == pg8::EpiInProj::O_CSB && WS_QA == pg8::EpiInProj::O_QA && WS_KA == pg8::EpiInProj::O_KA && WS_VA == pg8::EpiInProj::O_VA && WS_QB == pg8::EpiInProj::O_QB && WS_KB == pg8::EpiInProj::O_KB && WS_VB == pg8::EpiInProj::O_VB, "workspace map");
        pg8::gemm_phase<pg8::EpiInProj, pg8::StaticOrder, true, true>((PG8_LAS unsigned char*)lds, gm, S, E, tid);
        if constexpr (SYNC(2)) GRID_BAR();
    }

    if constexpr (RUN(3) || RUN(4)) {
        PHASE_PTRS();
        using BR = swa::BlockRef<swa::bf16, swa::bf16>;
        constexpr int NIT = 16 * 96;
        auto mk = [](int id, bf16* QA_, bf16* KA_, bf16* VA_, bf16* OA_, float* LSE_) -> BR {
            const int bh = id / 96, rem = id % 96, p = rem >> 5, blk = rem & 31, sh2 = 2 * p, d = 1 << sh2, nblk = 32 >> sh2, r = blk / nblk, qb = blk % nblk;
            BR br; const size_t base = ((size_t)bh * SEQ + r) * 128, qoff = (size_t)qb * 256 * d * 128;
            br.Q = (const swa::bf16*)(QA_ + base + qoff); br.K = (const swa::bf16*)(KA_ + base); br.V = (const swa::bf16*)(VA_ + base);
            br.O = (swa::bf16*)(OA_ + (size_t)p * ((size_t)T * 1024) + base + qoff);
            br.LSE = LSE_ + (size_t)p * (16 * SEQ) + (size_t)bh * SEQ + r + (size_t)qb * 256 * d;
            br.P0 = qb * 256; br.rs = 128 * d; br.ls = d; return br;
        };
        if constexpr (RUN(3)) {
        int id = bx;
        if (id < NIT) {
            BR cur = mk(id, QA, KA, VA, OA, LSE);
            swa::Seam<swa::bf16> Sm;
            swa::causal_swa_prime<swa::bf16, swa::bf16>(cur, 129, (char*)lds, Sm, tid);
#pragma unroll 1
            for (;;) {
                const bool last = id + G >= NIT;
                const BR nxt = last ? cur : mk(id + G, QA, KA, VA, OA, LSE);
                swa::causal_swa_block<swa::bf16, swa::bf16>(cur, nxt, SEQ, 129, (char*)lds, Sm, tid);
                if (last) break;
                cur = nxt; id += G;
            }
        }
        }
        __syncthreads();
        if constexpr (RUN(4))
        { int lz2_ = 0; asm volatile("" : "+v"(lz2_)); const int lane2 = (int)__builtin_amdgcn_mbcnt_hi(~0u, __builtin_amdgcn_mbcnt_lo(~0u, (unsigned)lz2_)); const int tid2 = wave_s * 64 + lane2;
          DiffSched S; S.vcu = (int)((blockIdx.x % 8) * (gridDim.x / 8) + blockIdx.x / 8); DiffUnit u;
          for (int i = 0; S.next(i, u); ++i) attn_body::attn_unit<8>(u.b, u.hq, u.hv, u.qb, (const attn_body::bf16*)QB, (const attn_body::bf16*)KB, (const attn_body::bf16*)VB, (attn_body::bf16*)(u.m ? OB1 : OB0), (char*)lds, tid2); }
        if constexpr (SYNC(4)) GRID_BAR();
    }

    if constexpr (RUN(5)) {
        PHASE_PTRS();
        const float lam = __expf(wave_sum(AIN(I_LQ1)[lane] * AIN(I_LK1)[lane])) - __expf(wave_sum(AIN(I_LQ2)[lane] * AIN(I_LK2)[lane])) + 0.2f;
        const int hl = lane >> 4, c = lane & 15;
        f32x4 ga0 = *(const f32x4*)(AIN(I_GOUTA) + c * 8), ga1 = *(const f32x4*)(AIN(I_GOUTA) + c * 8 + 4);
        f32x4 gb0 = *(const f32x4*)(AIN(I_GSUB) + c * 8) * 0.8f, gb1 = *(const f32x4*)(AIN(I_GSUB) + c * 8 + 4) * 0.8f;
#pragma unroll 1
        for (int t = gw; t < T; t += NGW) {
            const int b = t >> 13, s = t & 8191;
#pragma unroll
            for (int st = 0; st < 2; ++st) {
                const int head = 4 * st + hl; const size_t ro = (size_t)(b * 8 + head) * SEQ + s;
                const float l0 = LSE[ro], l1 = LSE[16 * SEQ + ro], l2 = LSE[32 * SEQ + ro];
                const float mx = fmaxf(l0, fmaxf(l1, l2)); float w0 = __expf(l0 - mx), w1 = __expf(l1 - mx), w2 = __expf(l2 - mx); const float inv = 1.0f / (w0 + w1 + w2); w0 *= inv; w1 *= inv; w2 *= inv;
                const v4u a = *(const v4u*)(OA + ro * 128 + c * 8), bq = *(const v4u*)(OA + (size_t)T * 1024 + ro * 128 + c * 8), cq = *(const v4u*)(OA + 2 * (size_t)T * 1024 + ro * 128 + c * 8);
                float o[8];
#pragma unroll
                for (int i = 0; i < 4; ++i) { o[2 * i] = w0 * bflo(a[i]) + w1 * bflo(bq[i]) + w2 * bflo(cq[i]); o[2 * i + 1] = w0 * bfhi(a[i]) + w1 * bfhi(bq[i]) + w2 * bfhi(cq[i]); }
                float ss = 0.f;
#pragma unroll
                for (int i = 0; i < 8; ++i) ss += o[i] * o[i];
                const float rstd = 1.0f / sqrtf(sum16(ss) * (1.0f / 128.0f) + RMS_EPS);
                v4u w; w.x = pk2(o[0] * rstd * ga0[0], o[1] * rstd * ga0[1]); w.y = pk2(o[2] * rstd * ga0[2], o[3] * rstd * ga0[3]); w.z = pk2(o[4] * rstd * ga1[0], o[5] * rstd * ga1[1]); w.w = pk2(o[6] * rstd * ga1[2], o[7] * rstd * ga1[3]);
                *(v4u*)(MIX + (size_t)t * DM + head * 128 + c * 8) = w;
            }
#pragma unroll
            for (int st = 0; st < 2; ++st) {
                const int head = 4 * st + hl; const size_t off = (size_t)t * 1024 + head * 128 + c * 8;
                const v4u a = *(const v4u*)(OB0 + off), bq = *(const v4u*)(OB1 + off);
                float o[8];
#pragma unroll
                for (int i = 0; i < 4; ++i) { o[2 * i] = bflo(a[i]) - lam * bflo(bq[i]); o[2 * i + 1] = bfhi(a[i]) - lam * bfhi(bq[i]); }
                float ss = 0.f;
#pragma unroll
                for (int i = 0; i < 8; ++i) ss += o[i] * o[i];
                const float rstd = 1.0f / sqrtf(sum16(ss) * (1.0f / 128.0f) + RMS_EPS);
                v4u w; w.x = pk2(o[0] * rstd * gb0[0], o[1] * rstd * gb0[1]); w.y = pk2(o[2] * rstd * gb0[2], o[3] * rstd * gb0[3]); w.z = pk2(o[4] * rstd * gb1[0], o[5] * rstd * gb1[1]); w.w = pk2(o[6] * rstd * gb1[2], o[7] * rstd * gb1[3]);
                *(v4u*)(MIX + (size_t)t * DM + 1024 + head * 128 + c * 8) = w;
            }
        }
        if constexpr (SYNC(5)) GRID_BAR();
    }

    if constexpr (RUN(6)) {
        PHASE_PTRS();
        pg8::Gemm gm{MIX, WOUT, T, DM, DM}; pg8::StaticOrder S; S.init(T, DM, G, bx);
        pg8::EpiF32Ssq E{Y, DM, SSQ};
        pg8::gemm_phase<pg8::EpiF32Ssq, pg8::StaticOrder, true, true>((PG8_LAS unsigned char*)lds, gm, S, E, tid);
        if constexpr (SYNC(6)) GRID_BAR();
    }

    if constexpr (RUN(7)) {
        PHASE_PTRS();
        const float* gpa = AIN(I_GPOSTA); const float* gpf = AIN(I_GPREF);
#pragma unroll 1
        for (int m = gw; m < T; m += NGW) {
            const int b = m >> 13; const float* mod = MOD + b * NMOD + 4 * lane;
            const float sq = wave_sum(lane < 32 ? SSQ[(size_t)m * 32 + lane] : 0.f);
            const float rstdy = 1.0f / sqrtf(sq * (1.0f / DM) + RMS_EPS);
            const float* yr = Y + (size_t)m * DM + 4 * lane; const float* xr = x + (size_t)m * DM + 4 * lane; float* x1r = ((float*)kargs_[20]) + (size_t)m * DM + 4 * lane;
            f32x4 v[8]; float ss = 0.f;
#pragma unroll
            for (int j = 0; j < 8; ++j) { const f32x4 yy = *(const f32x4*)(yr + 256 * j), xx = *(const f32x4*)(xr + 256 * j), gt = *(const f32x4*)(mod + 2 * DM + 256 * j), gp = *(const f32x4*)(gpa + 4 * lane + 256 * j);
                v[j] = xx + gt * ((yy * rstdy) * gp); *(f32x4*)(x1r + 256 * j) = v[j]; ss += (v[j][0] * v[j][0] + v[j][1] * v[j][1]) + (v[j][2] * v[j][2] + v[j][3] * v[j][3]); }
            const float rstd = 1.0f / sqrtf(wave_sum(ss) * (1.0f / DM) + RMS_EPS);
            bf16* hr = H2 + (size_t)m * DM + 4 * lane;
#pragma unroll
            for (int j = 0; j < 8; ++j) { const f32x4 gg = *(const f32x4*)(gpf + 4 * lane + 256 * j), s0 = *(const f32x4*)(mod + 3 * DM + 256 * j), s1 = *(const f32x4*)(mod + 4 * DM + 256 * j);
                const f32x4 o = (v[j] * rstd) * gg * (s1 + 1.0f) + s0; v2u w; w.x = pk2(o[0], o[1]); w.y = pk2(o[2], o[3]); *(v2u*)(hr + 256 * j) = w; }
        }
        if constexpr (SYNC(7)) GRID_BAR();
    }

    if constexpr (RUN(8)) {
        PHASE_PTRS();
        pg8::Gemm gm{H2, WGU, T, NGU, DM}; pg8::StaticOrder S; S.init(T, NGU, G, bx);
        pg8::EpiSwiGLU E{ACT, DFF};
        pg8::gemm_phase<pg8::EpiSwiGLU, pg8::StaticOrder, true, true>((PG8_LAS unsigned char*)lds, gm, S, E, tid);
        if constexpr (SYNC(8)) GRID_BAR();
    }

    if constexpr (RUN(9)) {
        PHASE_PTRS();
        pg8::Gemm gm{ACT, WDN, T, DM, DFF}; pg8::StaticOrder S; S.init(T, DM, G, bx);
        pg8::EpiF32Ssq E{F, DM, SSQ};
        pg8::gemm_phase<pg8::EpiF32Ssq, pg8::StaticOrder, true, true>((PG8_LAS unsigned char*)lds, gm, S, E, tid);
        if constexpr (SYNC(9)) GRID_BAR();
    }

    if constexpr (RUN(10)) {
        PHASE_PTRS();
        const float* gpf = AIN(I_GPOSTF);
#pragma unroll 1
        for (int m = gw; m < T; m += NGW) {
            const int b = m >> 13; const float* mod = MOD + b * NMOD + 5 * DM + 4 * lane;
            const float sq = wave_sum(lane < 32 ? SSQ[(size_t)m * 32 + lane] : 0.f);
            const float rstdf = 1.0f / sqrtf(sq * (1.0f / DM) + RMS_EPS);
            const float* fr = F + (size_t)m * DM + 4 * lane; float* orow = ((float*)kargs_[20]) + (size_t)m * DM + 4 * lane;
#pragma unroll
            for (int j = 0; j < 8; ++j) { const f32x4 ff = *(const f32x4*)(fr + 256 * j), xx = *(const f32x4*)(orow + 256 * j), gt = *(const f32x4*)(mod + 256 * j), gp = *(const f32x4*)(gpf + 4 * lane + 256 * j);
                *(f32x4*)(orow + 256 * j) = xx + gt * ((ff * rstdf) * gp); }
        }
    }
}

extern "C" void kernel_launch(void* const* d_in, const int* in_sizes, int n_in, void* d_out, int out_size, void* d_ws, size_t ws_size, hipStream_t stream) {
    static int grid = 0;
    if (grid == 0) {
        if (n_in != 20 || in_sizes[0] != T * DM || out_size != T * DM || ws_size < WS_END) { fprintf(stderr, "kernel_launch: unexpected shapes / workspace (n_in %d, ws %zu, need %zu)\n", n_in, ws_size, (size_t)WS_END); grid = -1; return; }
        int dev = 0, cus = 0, per_cu = 0;
        if (hipGetDevice(&dev) != hipSuccess || hipDeviceGetAttribute(&cus, hipDeviceAttributeMultiprocessorCount, dev) != hipSuccess) { grid = -1; return; }
#if defined(MK_ONE_LAUNCH)
        const void* fns[1] = {(const void*)fwd_megakernel<0>};
#else
        const void* fns[4] = {(const void*)fwd_megakernel<1>, (const void*)fwd_megakernel<2>, (const void*)fwd_megakernel<3>, (const void*)fwd_megakernel<4>};
#endif
        for (const void* fn : fns) if (hipFuncSetAttribute(fn, hipFuncAttributeMaxDynamicSharedMemorySize, LDS_BYTES) != hipSuccess) { fprintf(stderr, "kernel_launch: hipFuncSetAttribute failed\n"); grid = -1; return; }
        if (hipOccupancyMaxActiveBlocksPerMultiprocessor(&per_cu, fns[0], NWAVES * 64, LDS_BYTES) != hipSuccess || per_cu < 1) { fprintf(stderr, "kernel_launch: occupancy query says %d blocks per CU\n", per_cu); (void)hipGetLastError(); grid = -1; return; }
        grid = cus * per_cu;
    }
    if (grid < 0) return;
    Args a{};
    for (int i = 0; i < 20; ++i) a.in[i] = (const float*)d_in[i];
    a.out = (float*)d_out; a.ws = (unsigned char*)d_ws;
    void* kargs[] = {&a};
#if defined(MK_ONE_LAUNCH)
    hipError_t e = hipLaunchCooperativeKernel((const void*)fwd_megakernel<0>, dim3(grid), dim3(NWAVES * 64), kargs, LDS_BYTES, stream);
    if (e != hipSuccess) fprintf(stderr, "kernel_launch: cooperative launch failed: %s (grid %d)\n", hipGetErrorString(e), grid);
#else
    hipError_t e = hipLaunchCooperativeKernel((const void*)fwd_megakernel<1>, dim3(grid), dim3(NWAVES * 64), kargs, LDS_BYTES, stream);
    if (e != hipSuccess) fprintf(stderr, "kernel_launch: cooperative launch 1 failed: %s (grid %d)\n", hipGetErrorString(e), grid);
    hipLaunchKernelGGL(fwd_megakernel<2>, dim3(grid), dim3(NWAVES * 64), LDS_BYTES, stream, a);
    hipLaunchKernelGGL(fwd_megakernel<3>, dim3(grid), dim3(NWAVES * 64), LDS_BYTES, stream, a);
    e = hipLaunchCooperativeKernel((const void*)fwd_megakernel<4>, dim3(grid), dim3(NWAVES * 64), kargs, LDS_BYTES, stream);
    if (e != hipSuccess) fprintf(stderr, "kernel_launch: cooperative launch 4 failed: %s (grid %d)\n", hipGetErrorString(e), grid);
#endif
}
```
